# Optimizing an MI355X kernel written in HIP

```python
import math
import jax, jax.numpy as jnp
from jax import lax
import numpy as np

D_MODEL = 1024
BATCH = 8
SEQ = 4096
DEPTH = 4

CHUNK = 64
N_MIXERS = 4
EPS = 1e-6
GLA_HEADS = 4
GLA_DK = (D_MODEL // 2) // GLA_HEADS
GLA_DV = D_MODEL // GLA_HEADS
GLA_GATE_RANK = 16
GLA_TAU = 16.0
GLA_IN = 2 * GLA_HEADS * GLA_DK + 2 * GLA_HEADS * GLA_DV + GLA_GATE_RANK
POOL_WINDOWS = (2, 4, 8, 16)
POOL_GROUPS = len(POOL_WINDOWS)
POOL_GW = D_MODEL // POOL_GROUPS
SSD_DINNER = 2 * D_MODEL
SSD_HEADDIM = 64
SSD_HEADS = SSD_DINNER // SSD_HEADDIM
SSD_GROUPS = 4
SSD_HPG = SSD_HEADS // SSD_GROUPS
SSD_STATE = 128
SSD_CONV = 4
SSD_CONV_DIM = SSD_DINNER + 2 * SSD_GROUPS * SSD_STATE
SSD_IN = SSD_DINNER + SSD_CONV_DIM + SSD_HEADS
SB_HEADS = 16
SB_HEADDIM = D_MODEL // SB_HEADS
SB_QBLOCK = 128
FFN_DIM = 2816
FFN_CONV = 3

kernel_name = 'hybrid_chunk_causal_encoder'


def rms_normalize(x):
    xf = x.astype(jnp.float32)
    y = xf * lax.rsqrt(jnp.mean(xf * xf, axis=-1, keepdims=True) + EPS)
    return y.astype(x.dtype)


def rmsnorm(x, w):
    return rms_normalize(x) * w


def causal_dwconv(u, w, b):
    K = w.shape[0]
    L = u.shape[1]
    up = jnp.pad(u, ((0, 0), (K - 1, 0), (0, 0)))
    out = up[:, K - 1:K - 1 + L] * w[K - 1] + b
    for k in range(K - 1):
        out = out + up[:, k:k + L] * w[k]
    return out


def to_chunks(a):
    b_, l_ = a.shape[:2]
    return jnp.moveaxis(a.reshape(b_, l_ // CHUNK, CHUNK, *a.shape[2:]), 1, 0)


def from_chunks(a):
    a = jnp.moveaxis(a, 0, 1)
    return a.reshape(a.shape[0], a.shape[1] * a.shape[2], *a.shape[3:])


def gla_mixer(h, w_in, w_gate2, b_gate, norm_w, w_out):
    b_, l_, _ = h.shape
    hk, hv = GLA_HEADS * GLA_DK, GLA_HEADS * GLA_DV
    proj = h @ w_in
    q, k, v, r, glr = jnp.split(proj, [hk, 2 * hk, 2 * hk + hv, 2 * hk + 2 * hv], axis=-1)
    q = q.reshape(b_, l_, GLA_HEADS, GLA_DK).astype(jnp.float32) * (GLA_DK ** -0.5)
    k = k.reshape(b_, l_, GLA_HEADS, GLA_DK).astype(jnp.float32)
    v = v.reshape(b_, l_, GLA_HEADS, GLA_DV).astype(jnp.float32)
    log_a = jax.nn.log_sigmoid((glr @ w_gate2 + b_gate).astype(jnp.float32)) / GLA_TAU
    log_a = log_a.reshape(b_, l_, GLA_HEADS, GLA_DK)
    qc, kc, vc, lac = to_chunks(q), to_chunks(k), to_chunks(v), to_chunks(log_a)
    g = jnp.cumsum(lac, axis=2)
    g_end = g[:, :, -1]
    k_dec = kc * jnp.exp(g_end[:, :, None] - g)

    def body(state, inp):
        q_c, kd_c, v_c, ge_c = inp
        state = state * jnp.exp(ge_c)[..., None] + jnp.einsum('bshk,bshv->bhkv', kd_c, v_c)
        o = jnp.einsum('bqhk,bhkv->bqhv', q_c, state)
        return state, o

    s0 = jnp.zeros((b_, GLA_HEADS, GLA_DK, GLA_DV), jnp.float32)
    _, o = lax.scan(body, s0, (qc, k_dec, vc, g_end))
    o = rms_normalize(from_chunks(o)).reshape(b_, l_, hv) * norm_w
    o = o.astype(h.dtype) * jax.nn.silu(r)
    return o @ w_out


def pool_mixer(h, w_grp, b_grp, scale):
    b_, l_, d_ = h.shape
    hf = h.astype(jnp.float32)
    cs = jnp.concatenate([jnp.zeros((b_, 1, d_), jnp.float32), jnp.cumsum(hf, axis=1)], axis=1)
    t1 = jnp.arange(1, l_ + 1, dtype=jnp.float32)
    outs = []
    for gi, win in enumerate(POOL_WINDOWS):
        sl = slice(gi * POOL_GW, (gi + 1) * POOL_GW)
        c = cs[..., sl]
        lower = jnp.concatenate([jnp.zeros((b_, win - 1, POOL_GW), jnp.float32), c[:, :l_ + 1 - win]], axis=1)
        mean = (c[:, 1:] - lower) / jnp.minimum(t1, float(win))[None, :, None]
        dlt = (mean - hf[..., sl]).astype(h.dtype)
        outs.append(dlt @ w_grp[gi] + b_grp[gi])
    return jnp.concatenate(outs, axis=-1) * scale


def ssd_mixer(h, w_in, conv_w, conv_b, dt_bias, a_log, d_skip, norm_w, w_out):
    b_, l_, _ = h.shape
    G, HG, P, N = SSD_GROUPS, SSD_HPG, SSD_HEADDIM, SSD_STATE
    proj = h @ w_in
    z, xbc, dt = jnp.split(proj, [SSD_DINNER, SSD_DINNER + SSD_CONV_DIM], axis=-1)
    xbc = jax.nn.silu(causal_dwconv(xbc, conv_w, conv_b))
    xs, bm, cm = jnp.split(xbc, [SSD_DINNER, SSD_DINNER + G * N], axis=-1)
    xs = xs.reshape(b_, l_, G, HG, P)
    bm = bm.reshape(b_, l_, G, N)
    cm = cm.reshape(b_, l_, G, N)
    dt = jax.nn.softplus((dt + dt_bias).astype(jnp.float32)).reshape(b_, l_, G, HG)
    a_h = -jnp.exp(a_log.astype(jnp.float32)).reshape(G, HG)
    causal = jnp.tril(jnp.ones((CHUNK, CHUNK), bool))

    def body(state, inp):
        x_c, b_c, c_c, dt_c = inp
        acs = jnp.cumsum(dt_c * a_h, axis=1)
        seg = acs[:, :, None] - acs[:, None, :]
        lmat = jnp.exp(jnp.where(causal[None, :, :, None, None], seg, -jnp.inf))
        xdt = x_c * dt_c[..., None]
        cb = jnp.einsum('btgn,bsgn->btsg', c_c, b_c)
        y = jnp.einsum('btsg,btsgh,bsghp->btghp', cb, lmat, xdt)
        y = y + jnp.einsum('btgn,bghpn,btgh->btghp', c_c, state, jnp.exp(acs))
        decay_end = jnp.exp(acs[:, -1:] - acs)
        state = state * jnp.exp(acs[:, -1])[..., None, None] + jnp.einsum('bsgn,bsgh,bsghp->bghpn', b_c, decay_end, xdt)
        return state, y

    s0 = jnp.zeros((b_, G, HG, P, N), jnp.float32)
    _, ys = lax.scan(body, s0, (to_chunks(xs), to_chunks(bm), to_chunks(cm), to_chunks(dt)))
    y = from_chunks(ys) + d_skip.reshape(G, HG)[..., None] * xs
    y = y.reshape(b_, l_, SSD_DINNER) * jax.nn.silu(z)
    y = rms_normalize(y.reshape(b_, l_, G, SSD_DINNER // G)).reshape(b_, l_, SSD_DINNER) * norm_w
    return y.astype(h.dtype) @ w_out


def sb_mixer(h, w_qkv, w_out):
    b_, l_, _ = h.shape
    q, k, v = jnp.split(h @ w_qkv, 3, axis=-1)
    q = q.reshape(b_, l_, SB_HEADS, SB_HEADDIM).transpose(0, 2, 1, 3) * (SB_HEADDIM ** -0.5)
    k = k.reshape(b_, l_, SB_HEADS, SB_HEADDIM).transpose(0, 2, 1, 3)
    v = v.reshape(b_, l_, SB_HEADS, SB_HEADDIM).transpose(0, 2, 1, 3)
    nb = l_ // SB_QBLOCK
    qb = jnp.moveaxis(q.reshape(b_, SB_HEADS, nb, SB_QBLOCK, SB_HEADDIM), 2, 0)
    starts = jnp.arange(nb, dtype=jnp.int32) * SB_QBLOCK
    key_pos = jnp.arange(l_, dtype=jnp.int32)

    def block(inp):
        q_i, start = inp
        zt = jnp.einsum('bhqd,bhkd->bhqk', q_i, k).astype(jnp.float32)
        qpos = start + jnp.arange(SB_QBLOCK, dtype=jnp.int32)
        mask = key_pos[None, :] < qpos[:, None]
        log_1mb = jnp.where(mask, jax.nn.log_sigmoid(-zt), 0.0)
        rc = lax.cumsum(log_1mb, axis=3, reverse=True)
        surv = jnp.concatenate([rc[..., 1:], jnp.zeros_like(rc[..., :1])], axis=-1)
        att = jnp.where(mask, jnp.exp(jax.nn.log_sigmoid(zt) + surv), 0.0)
        return jnp.einsum('bhqk,bhkd->bhqd', att.astype(v.dtype), v)

    o = lax.map(block, (qb, starts))
    o = jnp.moveaxis(o, 0, 2).reshape(b_, SB_HEADS, l_, SB_HEADDIM)
    o = o.transpose(0, 2, 1, 3).reshape(b_, l_, D_MODEL)
    return o @ w_out


def conv_ffn(h, w_up, conv_w, conv_b, w_down):
    u = causal_dwconv(h @ w_up, conv_w, conv_b)
    g, val = jnp.split(u, 2, axis=-1)
    return (jax.nn.silu(g) * val) @ w_down


def setup_inputs(seed: int = 0) -> dict:
    key = jax.random.key(seed)
    ks = list(jax.random.split(key, 40))
    f32 = jnp.float32

    def nrm(i, shape, scale):
        return jax.random.normal(ks[i], shape, f32) * scale

    n_a = len(range(0, DEPTH, N_MIXERS))
    n_b = len(range(1, DEPTH, N_MIXERS))
    n_c = len(range(2, DEPTH, N_MIXERS))
    n_d = len(range(3, DEPTH, N_MIXERS))
    dt0 = jnp.exp(jax.random.uniform(ks[20], (n_c, SSD_HEADS), f32) * (math.log(0.1) - math.log(0.001)) + math.log(0.001))
    return {
        'x': nrm(0, (BATCH, SEQ, D_MODEL), 1.0),
        'mix_norm_w': 1.0 + nrm(1, (DEPTH, D_MODEL), 0.02),
        'ffn_norm_w': 1.0 + nrm(2, (DEPTH, D_MODEL), 0.02),
        'final_norm_w': 1.0 + nrm(3, (D_MODEL,), 0.02),
        'gla_w_in': nrm(4, (n_a, D_MODEL, GLA_IN), D_MODEL ** -0.5),
        'gla_w_gate2': nrm(5, (n_a, GLA_GATE_RANK, GLA_HEADS * GLA_DK), GLA_GATE_RANK ** -0.5),
        'gla_b_gate': nrm(6, (n_a, GLA_HEADS * GLA_DK), 0.1),
        'gla_norm_w': 1.0 + nrm(7, (n_a, GLA_HEADS * GLA_DV), 0.02),
        'gla_w_out': nrm(8, (n_a, GLA_HEADS * GLA_DV, D_MODEL), (GLA_HEADS * GLA_DV) ** -0.5),
        'pool_w': nrm(9, (n_b, POOL_GROUPS, POOL_GW, POOL_GW), POOL_GW ** -0.5),
        'pool_b': nrm(10, (n_b, POOL_GROUPS, POOL_GW), 0.02),
        'pool_scale': 1.0 + nrm(11, (n_b, D_MODEL), 0.02),
        'ssd_w_in': nrm(12, (n_c, D_MODEL, SSD_IN), D_MODEL ** -0.5),
        'ssd_conv_w': nrm(13, (n_c, SSD_CONV, SSD_CONV_DIM), SSD_CONV ** -0.5),
        'ssd_conv_b': nrm(14, (n_c, SSD_CONV_DIM), 0.02),
        'ssd_dt_bias': dt0 + jnp.log(-jnp.expm1(-dt0)),
        'ssd_a_log': jnp.log(jax.random.uniform(ks[15], (n_c, SSD_HEADS), f32, 1.0, 16.0)),
        'ssd_d': 1.0 + nrm(16, (n_c, SSD_HEADS), 0.02),
        'ssd_norm_w': 1.0 + nrm(17, (n_c, SSD_DINNER), 0.02),
        'ssd_w_out': nrm(18, (n_c, SSD_DINNER, D_MODEL), SSD_DINNER ** -0.5),
        'sb_w_qkv': nrm(19, (n_d, D_MODEL, 3 * D_MODEL), D_MODEL ** -0.5),
        'sb_w_out': nrm(21, (n_d, D_MODEL, D_MODEL), D_MODEL ** -0.5),
        'ffn_w_up': nrm(22, (DEPTH, D_MODEL, 2 * FFN_DIM), D_MODEL ** -0.5),
        'ffn_conv_w': nrm(23, (DEPTH, FFN_CONV, 2 * FFN_DIM), FFN_CONV ** -0.5),
        'ffn_conv_b': nrm(24, (DEPTH, 2 * FFN_DIM), 0.02),
        'ffn_w_down': nrm(25, (DEPTH, FFN_DIM, D_MODEL), FFN_DIM ** -0.5),
    }


def reference(x, mix_norm_w, ffn_norm_w, final_norm_w,
              gla_w_in, gla_w_gate2, gla_b_gate, gla_norm_w, gla_w_out,
              pool_w, pool_b, pool_scale,
              ssd_w_in, ssd_conv_w, ssd_conv_b, ssd_dt_bias, ssd_a_log, ssd_d, ssd_norm_w, ssd_w_out,
              sb_w_qkv, sb_w_out,
              ffn_w_up, ffn_conv_w, ffn_conv_b, ffn_w_down):
    for i in range(DEPTH):
        m, j = i % N_MIXERS, i // N_MIXERS
        h = rmsnorm(x, mix_norm_w[i])
        if m == 0:
            y = gla_mixer(h, gla_w_in[j], gla_w_gate2[j], gla_b_gate[j], gla_norm_w[j], gla_w_out[j])
        elif m == 1:
            y = pool_mixer(h, pool_w[j], pool_b[j], pool_scale[j])
        elif m == 2:
            y = ssd_mixer(h, ssd_w_in[j], ssd_conv_w[j], ssd_conv_b[j], ssd_dt_bias[j], ssd_a_log[j],
                          ssd_d[j], ssd_norm_w[j], ssd_w_out[j])
        else:
            y = sb_mixer(h, sb_w_qkv[j], sb_w_out[j])
        x = x + y.astype(x.dtype)
        h = rmsnorm(x, ffn_norm_w[i])
        x = x + conv_ffn(h, ffn_w_up[i], ffn_conv_w[i], ffn_conv_b[i], ffn_w_down[i]).astype(x.dtype)
    return rmsnorm(x, final_norm_w)
```

```cpp
#include <hip/hip_runtime.h>
#include <hip/hip_cooperative_groups.h>
#include <cstdio>
#include <cstdint>
namespace cg = cooperative_groups;

#define LAS __attribute__((address_space(3)))
typedef unsigned short bf16_t;
typedef short bf16x8 __attribute__((ext_vector_type(8)));
typedef float f32x4 __attribute__((ext_vector_type(4)));
typedef unsigned u32x4 __attribute__((ext_vector_type(4)));
typedef unsigned u32x2 __attribute__((ext_vector_type(2)));

constexpr int NTOK = 32768, DM = 1024, SEQL = 4096;
constexpr int FFD = 2816;
constexpr size_t MiB = 1u << 20;
constexpr size_t WS_RSSP = 0;
constexpr size_t RSSP_STRIDE = (size_t)NTOK * 4;
constexpr size_t WS_W = 4 * MiB;
constexpr size_t W_FFN_STRIDE = 16 * MiB + MiB / 2;
constexpr size_t W_FFN_DOWN_OFF = 11 * MiB;
constexpr size_t W_GLA_IN = WS_W + 66 * MiB;
constexpr size_t W_GLA_OUT = W_GLA_IN + 6 * MiB + MiB / 2;
constexpr size_t W_POOL = W_GLA_OUT + 2 * MiB;
constexpr size_t W_SSD_IN = W_POOL + MiB / 2;
constexpr size_t W_SSD_OUT = W_SSD_IN + 10 * MiB + MiB / 2;
constexpr size_t W_SB_QKV = W_SSD_OUT + 4 * MiB;
constexpr size_t W_SB_OUT = W_SB_QKV + 6 * MiB;
constexpr size_t W_END = W_SB_OUT + 2 * MiB;
constexpr size_t WS_XB = 103 * MiB;
constexpr size_t WS_BIG = 168 * MiB;
constexpr size_t WS_NEED = 492 * MiB;
static_assert(W_END <= 102 * MiB, "weights map");
constexpr size_t BIG_GLA_KDT = 192 * MiB, BIG_GLA_EG = 224 * MiB, BIG_GLA_GLR = 225 * MiB, BIG_GLA_OPRE = 227 * MiB;
constexpr size_t BIG_SSD_DT = 320 * MiB;
constexpr size_t BIG_SB_AO = 192 * MiB;

typedef __bf16 bf2_t __attribute__((ext_vector_type(2)));
typedef float f2_t __attribute__((ext_vector_type(2)));
__device__ __forceinline__ unsigned cvt_pk_bf16(float lo, float hi) { f2_t v = {lo, hi}; bf2_t r = __builtin_convertvector(v, bf2_t); return __builtin_bit_cast(unsigned, r); }
__device__ __forceinline__ float bflo(unsigned w) { return __uint_as_float(w << 16); }
__device__ __forceinline__ float bfhi(unsigned w) { return __uint_as_float(w & 0xffff0000u); }
__device__ __forceinline__ float bf1(bf16_t h) { return __uint_as_float((unsigned)h << 16); }
__device__ __forceinline__ bf16_t f2bf(float f) { return (bf16_t)(cvt_pk_bf16(f, 0.f) & 0xffffu); }
__device__ __forceinline__ float fast_silu(float x) { return x * __builtin_amdgcn_rcpf(1.f + __expf(-x)); }
__device__ __forceinline__ float row_rstd(const float* rssp, int row) {
    const f32x4 a = *(const f32x4*)(rssp + (size_t)row * 4);
    const float s = (a.x + a.y) + (a.z + a.w);
    return rsqrtf(s * (1.0f / 1024.0f) + 1e-6f);
}
#define LBAR() do { asm volatile("s_waitcnt lgkmcnt(0)" ::: "memory"); __builtin_amdgcn_s_barrier(); asm volatile("" ::: "memory"); } while (0)
__device__ __forceinline__ int swz144(int r, int sb) { return r * 128 + ((((sb >> 4) ^ (((r >> 3) ^ (r >> 1)) & 7)) << 4) | (sb & 15)); }
#define MFMA16(a, b, c) __builtin_amdgcn_mfma_f32_16x16x32_bf16((a), (b), (c), 0, 0, 0)
__device__ __forceinline__ bf16x8 ldsfrag(const unsigned char* p) { return *(const bf16x8*)p; }

__device__ __forceinline__ float prev_lane16(float x) { const int v = __builtin_bit_cast(int, x); return __builtin_bit_cast(float, __builtin_amdgcn_update_dpp(v, v, 0x111  , 0xf, 0xf, false)); }
namespace pg8 {
constexpr int BM = 256, BK = 64, HALF = 128, HTB = HALF * BK * 2, STAGE_BYTES = 8 * HTB, NXCD = 8, WGM = 8;
__host__ __device__ __forceinline__ int lds_byte(int r, int c) { const int st = (r >> 4) * 2 + (c >> 5), rr = r & 15, cc = c & 31, ob = rr * 64 + cc * 2; return st * 1024 + (ob ^ (((ob >> 9) & 1) << 5)); }
__host__ __device__ __forceinline__ void stage_rc(int b, int& R, int& C) { const int st = b / 1024, sb = b % 1024, swz = sb ^ (((sb >> 9) & 1) << 5); R = (st >> 1) * 16 + swz / 64; C = (st & 1) * 32 + (swz % 64) / 2; }
__host__ __device__ __forceinline__ int perm32(int rho) { const int n = rho >> 4, i = rho & 15; return 8 * (i >> 2) + 4 * n + (i & 3); }

struct Unit { int pm, pn; long a_off, b_off; };

struct Sched {
    int nM, nN, nwg, G, c, mode; long a_tile, a_pn, b_tile;
    __device__ __forceinline__ void init(int nM_, int nN_, int G_, int c_, int mode_, long a_tile_, long a_pn_, long b_tile_) { nM = nM_; nN = nN_; nwg = nM * nN; G = G_; c = c_; mode = mode_; a_tile = a_tile_; a_pn = a_pn_; b_tile = b_tile_; }
    __device__ __forceinline__ bool next(int i, Unit& u) const {
        const long L = (long)i * G + c; if (L >= nwg) return false;
        int wgid = (int)L; { const int q = nwg / NXCD, r = nwg % NXCD, xcd = wgid % NXCD, off = wgid / NXCD; wgid = (xcd < r ? xcd * (q + 1) : r * (q + 1) + (xcd - r) * q) + off; }
        const int nig = WGM * nN, gid = wgid / nig, fm = gid * WGM, gsz = (nM - fm) < WGM ? (nM - fm) : WGM;
        u.pm = fm + ((wgid % nig) % gsz); u.pn = (wgid % nig) / gsz;
        if (mode == 0) u.a_off = (long)u.pm * a_tile + (long)u.pn * a_pn;
        else { const int b = u.pm / 17, ii = u.pm - b * 17; u.a_off = ((long)b * 4096 + 254 * ii - 2) * 2048; }
        u.b_off = (long)u.pn * b_tile; return true;
    }
};

struct EpiProj {
    static constexpr bool PERM = true, APERM = false;
    bf16_t* O; int ldc; const float* rssp; int sp_tile; float* sp_out; int sp_ld;
    __device__ __forceinline__ bool narrow(const Unit& u) const { return u.pn == sp_tile; }
    __device__ __forceinline__ void operator()(f32x4 (&acc)[2][2][4][2], const Unit& u, int wr, int wc, int fr, int fq, unsigned char* lds) const {
        const int row0 = u.pm * BM + wr * 64 + fr;
        float rs[2][4];
#pragma unroll
        for (int ai = 0; ai < 2; ++ai)
#pragma unroll
            for (int m = 0; m < 4; ++m) rs[ai][m] = row_rstd(rssp, row0 + ai * HALF + m * 16);
        if (u.pn == sp_tile) {
            if (wc == 0) {
#pragma unroll
                for (int ai = 0; ai < 2; ++ai)
#pragma unroll
                    for (int m = 0; m < 4; ++m)
#pragma unroll
                        for (int n = 0; n < 2; ++n) { const int c = 8 * fq + 4 * n; if (c < sp_ld) *(f32x4*)(sp_out + (size_t)(row0 + ai * HALF + m * 16) * sp_ld + c) = acc[ai][0][m][n] * rs[ai][m]; }
            }
            return;
        }
        const int col0 = u.pn * BM + wc * 32 + 8 * fq;
#pragma unroll
        for (int ai = 0; ai < 2; ++ai)
#pragma unroll
            for (int m = 0; m < 4; ++m) { bf16_t* rowp = O + (size_t)(row0 + ai * HALF + m * 16) * ldc + col0; const float s = rs[ai][m];
#pragma unroll
                for (int bj = 0; bj < 2; ++bj) { const f32x4 v0 = acc[ai][bj][m][0] * s, v1 = acc[ai][bj][m][1] * s;
                    u32x4 w; w.x = cvt_pk_bf16(v0[0], v0[1]); w.y = cvt_pk_bf16(v0[2], v0[3]); w.z = cvt_pk_bf16(v1[0], v1[1]); w.w = cvt_pk_bf16(v1[2], v1[3]);
                    *(u32x4*)(rowp + bj * HALF) = w; } }
    }
};

struct EpiSsdIn {
    static constexpr bool PERM = true, APERM = true;
    bf16_t* O; const float* rssp; float* dt_out; const float* cw; const float* cb; float* side;
    __device__ __forceinline__ bool narrow(const Unit& u) const { return u.pn == 20; }
    __device__ __forceinline__ void operator()(f32x4 (&acc)[2][2][4][2], const Unit& u, int wr, int wc, int fr, int fq, unsigned char* lds) const {
        const int ii = u.pm & 15; const int rowbase = u.pm * BM;
        float* bnd = (float*)(lds + STAGE_BYTES);
#pragma unroll
        for (int ai = 0; ai < 2; ++ai)
#pragma unroll
            for (int m = 0; m < 4; ++m) { const float rs = row_rstd(rssp, rowbase + ai * HALF + wr * 64 + 4 * fr + m);
#pragma unroll
                for (int bj = 0; bj < 2; ++bj)
#pragma unroll
                    for (int n = 0; n < 2; ++n) acc[ai][bj][m][n] = acc[ai][bj][m][n] * rs; }
        const bool convt = (u.pn >= 8 && u.pn < 20);
        if (convt) {
            const int xc0 = (u.pn - 8) * 256 + wc * 32 + 8 * fq;
            if (fr == 15) {
#pragma unroll
                for (int ai = 0; ai < 2; ++ai)
#pragma unroll
                    for (int mm = 0; mm < 3; ++mm)
#pragma unroll
                        for (int bj = 0; bj < 2; ++bj)
#pragma unroll
                            for (int n = 0; n < 2; ++n) *(f32x4*)(bnd + ((ai * 2 + wr) * 3 + mm) * 256 + bj * HALF + wc * 32 + 8 * fq + 4 * n) = acc[ai][bj][1 + mm][n];
                if (wr == 1) {
#pragma unroll
                    for (int mm = 0; mm < 3; ++mm)
#pragma unroll
                        for (int bj = 0; bj < 2; ++bj)
#pragma unroll
                            for (int n = 0; n < 2; ++n) *(f32x4*)(side + ((size_t)u.pm * 6 + 3 + mm) * 3072 + xc0 + bj * HALF + 4 * n) = acc[1][bj][1 + mm][n];
                }
            }
            if (fr == 0 && wr == 0) {
#pragma unroll
                for (int mm = 0; mm < 3; ++mm)
#pragma unroll
                    for (int bj = 0; bj < 2; ++bj)
#pragma unroll
                        for (int n = 0; n < 2; ++n) *(f32x4*)(side + ((size_t)u.pm * 6 + mm) * 3072 + xc0 + bj * HALF + 4 * n) = acc[0][bj][mm][n];
            }
        }
        asm volatile("s_waitcnt lgkmcnt(0)" ::: "memory"); __builtin_amdgcn_s_barrier(); asm volatile("" ::: "memory");
        if (convt) {
            const int xc0 = (u.pn - 8) * 256 + wc * 32 + 8 * fq;
#pragma unroll
            for (int bj = 0; bj < 2; ++bj)
#pragma unroll
                for (int n = 0; n < 2; ++n) { const int xc = xc0 + bj * HALF + 4 * n;
                    const f32x4 w0 = *(const f32x4*)(cw + xc), w1 = *(const f32x4*)(cw + 3072 + xc), w2 = *(const f32x4*)(cw + 2 * 3072 + xc), w3 = *(const f32x4*)(cw + 3 * 3072 + xc), bb = *(const f32x4*)(cb + xc);
#pragma unroll
                    for (int ai = 0; ai < 2; ++ai) { const int pblk = ai * 2 + wr - 1;
                        f32x4 p1, p2, p3;
#pragma unroll
                        for (int e = 0; e < 4; ++e) { p1[e] = prev_lane16(acc[ai][bj][1][n][e]); p2[e] = prev_lane16(acc[ai][bj][2][n][e]); p3[e] = prev_lane16(acc[ai][bj][3][n][e]); }
                        if (fr == 0) { if (pblk >= 0) { const float* bp = bnd + (pblk * 3) * 256 + bj * HALF + wc * 32 + 8 * fq + 4 * n; p1 = *(const f32x4*)(bp); p2 = *(const f32x4*)(bp + 256); p3 = *(const f32x4*)(bp + 512); }
                                       else { p1 = (f32x4){0.f, 0.f, 0.f, 0.f}; p2 = p1; p3 = p1; } }
                        const f32x4 v0 = acc[ai][bj][0][n], v1 = acc[ai][bj][1][n], v2 = acc[ai][bj][2][n], v3 = acc[ai][bj][3][n];
                        f32x4 o[4];
                        o[0] = bb + w3 * v0 + w2 * p3 + w1 * p2 + w0 * p1; o[1] = bb + w3 * v1 + w2 * v0 + w1 * p3 + w0 * p2;
                        o[2] = bb + w3 * v2 + w2 * v1 + w1 * v0 + w0 * p3; o[3] = bb + w3 * v3 + w2 * v2 + w1 * v1 + w0 * v0;
#pragma unroll
                        for (int m = 0; m < 4; ++m) { const int tau = ai * HALF + wr * 64 + 4 * fr + m;
                            if (tau >= 3 || ii == 0) { u32x2 w; w.x = cvt_pk_bf16(fast_silu(o[m][0]), fast_silu(o[m][1])); w.y = cvt_pk_bf16(fast_silu(o[m][2]), fast_silu(o[m][3]));
                                *(u32x2*)(O + (size_t)(rowbase + tau) * 5120 + 2048 + xc) = w; } } } }
        } else if (u.pn == 20) {
            if (wc == 0) {
#pragma unroll
                for (int ai = 0; ai < 2; ++ai)
#pragma unroll
                    for (int m = 0; m < 4; ++m)
#pragma unroll
                        for (int n = 0; n < 2; ++n) *(f32x4*)(dt_out + (size_t)(rowbase + ai * HALF + wr * 64 + 4 * fr + m) * 32 + 8 * fq + 4 * n) = acc[ai][0][m][n];
            }
        } else {
            const int col0 = u.pn * BM + wc * 32 + 8 * fq;
#pragma unroll
            for (int ai = 0; ai < 2; ++ai)
#pragma unroll
                for (int m = 0; m < 4; ++m) { bf16_t* rowp = O + (size_t)(rowbase + ai * HALF + wr * 64 + 4 * fr + m) * 5120 + col0;
#pragma unroll
                    for (int bj = 0; bj < 2; ++bj) { const f32x4 v0 = acc[ai][bj][m][0], v1 = acc[ai][bj][m][1];
                        u32x4 w; w.x = cvt_pk_bf16(v0[0], v0[1]); w.y = cvt_pk_bf16(v0[2], v0[3]); w.z = cvt_pk_bf16(v1[0], v1[1]); w.w = cvt_pk_bf16(v1[2], v1[3]);
                        *(u32x4*)(rowp + bj * HALF) = w; } }
        }
    }
};

struct EpiResid {
    static constexpr bool PERM = true, APERM = false;
    bf16_t* xb; float* rssp_out; const float* bias; const float* scale; int dry;
    __device__ __forceinline__ bool narrow(const Unit&) const { return false; }
    __device__ __forceinline__ void operator()(f32x4 (&acc)[2][2][4][2], const Unit& u, int wr, int wc, int fr, int fq, unsigned char* lds) const {
        const int col0 = u.pn * BM + wc * 32 + 8 * fq;
        float* part = (float*)(lds + STAGE_BYTES);
        if (bias) {
#pragma unroll
            for (int bj = 0; bj < 2; ++bj)
#pragma unroll
                for (int n = 0; n < 2; ++n) { const f32x4 bv = *(const f32x4*)(bias + col0 + bj * HALF + 4 * n), sv = *(const f32x4*)(scale + col0 + bj * HALF + 4 * n);
#pragma unroll
                    for (int ai = 0; ai < 2; ++ai)
#pragma unroll
                        for (int m = 0; m < 4; ++m) acc[ai][bj][m][n] = (acc[ai][bj][m][n] + bv) * sv; }
        }
#pragma unroll
        for (int ai = 0; ai < 2; ++ai) {
            u32x4 xo[4][2];
#pragma unroll
            for (int m = 0; m < 4; ++m)
#pragma unroll
                for (int bj = 0; bj < 2; ++bj) xo[m][bj] = *(const u32x4*)(xb + (size_t)(u.pm * BM + ai * HALF + wr * 64 + m * 16 + fr) * DM + col0 + bj * HALF);
#pragma unroll
            for (int m = 0; m < 4; ++m) { const int row = u.pm * BM + ai * HALF + wr * 64 + m * 16 + fr; bf16_t* rp = xb + (size_t)row * DM + col0; float ss = 0.f;
#pragma unroll
                for (int bj = 0; bj < 2; ++bj) { const u32x4 xv = xo[m][bj]; const f32x4 v0 = acc[ai][bj][m][0], v1 = acc[ai][bj][m][1];
                    const float x0 = bflo(xv.x) + v0[0], x1 = bfhi(xv.x) + v0[1], x2 = bflo(xv.y) + v0[2], x3 = bfhi(xv.y) + v0[3];
                    const float x4 = bflo(xv.z) + v1[0], x5 = bfhi(xv.z) + v1[1], x6 = bflo(xv.w) + v1[2], x7 = bfhi(xv.w) + v1[3];
                    ss += ((x0 * x0 + x1 * x1) + (x2 * x2 + x3 * x3)) + ((x4 * x4 + x5 * x5) + (x6 * x6 + x7 * x7));
                    u32x4 w; w.x = cvt_pk_bf16(x0, x1); w.y = cvt_pk_bf16(x2, x3); w.z = cvt_pk_bf16(x4, x5); w.w = cvt_pk_bf16(x6, x7);
                    if (!dry) *(u32x4*)(rp + bj * HALF) = w; }
                ss += __shfl_xor(ss, 16); ss += __shfl_xor(ss, 32);
                if (fq == 0) part[wc * 256 + ai * HALF + wr * 64 + m * 16 + fr] = ss; }
        }
        asm volatile("s_waitcnt lgkmcnt(0)" ::: "memory"); __builtin_amdgcn_s_barrier(); asm volatile("" ::: "memory");
        { const int t = (wr * 4 + wc) * 64 + fq * 16 + fr;
          if (t < 256 && !dry) rssp_out[(size_t)(u.pm * BM + t) * 4 + u.pn] = (part[t] + part[256 + t]) + (part[512 + t] + part[768 + t]); }
    }
};

struct EpiFfnUp {
    static constexpr bool PERM = true, APERM = true;
    bf16_t* act; const float* rssp; const float* cw; const float* cb; float* side;
    __device__ __forceinline__ bool narrow(const Unit&) const { return false; }
    __device__ __forceinline__ void operator()(f32x4 (&acc)[2][2][4][2], const Unit& u, int wr, int wc, int fr, int fq, unsigned char* lds) const {
        const int ii = u.pm & 15; const int rowbase = u.pm * BM;
        float* bnd = (float*)(lds + STAGE_BYTES);
        const int ch0 = u.pn * 128 + wc * 32 + 8 * fq;
        f32x4 wq[8];
        wq[0] = *(const f32x4*)(cw + ch0); wq[1] = *(const f32x4*)(cw + 5632 + ch0); wq[2] = *(const f32x4*)(cw + 2 * 5632 + ch0); wq[3] = *(const f32x4*)(cb + ch0);
        wq[4] = *(const f32x4*)(cw + FFD + ch0); wq[5] = *(const f32x4*)(cw + 5632 + FFD + ch0); wq[6] = *(const f32x4*)(cw + 2 * 5632 + FFD + ch0); wq[7] = *(const f32x4*)(cb + FFD + ch0);
#pragma unroll
        for (int ai = 0; ai < 2; ++ai)
#pragma unroll
            for (int m = 0; m < 4; ++m) { const float rs = row_rstd(rssp, rowbase + ai * HALF + wr * 64 + 4 * fr + m);
#pragma unroll
                for (int bj = 0; bj < 2; ++bj)
#pragma unroll
                    for (int n = 0; n < 2; ++n) acc[ai][bj][m][n] = acc[ai][bj][m][n] * rs; }
        if (fr == 15) {
#pragma unroll
            for (int ai = 0; ai < 2; ++ai)
#pragma unroll
                for (int mm = 0; mm < 2; ++mm)
#pragma unroll
                    for (int bj = 0; bj < 2; ++bj)
#pragma unroll
                        for (int n = 0; n < 2; ++n) *(f32x4*)(bnd + ((ai * 2 + wr) * 2 + mm) * 256 + bj * HALF + wc * 32 + 8 * fq + 4 * n) = acc[ai][bj][2 + mm][n];
            if (wr == 1) {
#pragma unroll
                for (int mm = 0; mm < 2; ++mm)
#pragma unroll
                    for (int bj = 0; bj < 2; ++bj)
#pragma unroll
                        for (int n = 0; n < 2; ++n) *(f32x4*)(side + ((size_t)u.pm * 4 + 2 + mm) * 5632 + u.pn * 256 + bj * HALF + wc * 32 + 8 * fq + 4 * n) = acc[1][bj][2 + mm][n];
            }
        }
        if (fr == 0 && wr == 0) {
#pragma unroll
            for (int mm = 0; mm < 2; ++mm)
#pragma unroll
                for (int bj = 0; bj < 2; ++bj)
#pragma unroll
                    for (int n = 0; n < 2; ++n) *(f32x4*)(side + ((size_t)u.pm * 4 + mm) * 5632 + u.pn * 256 + bj * HALF + wc * 32 + 8 * fq + 4 * n) = acc[0][bj][mm][n];
        }
        asm volatile("s_waitcnt lgkmcnt(0)" ::: "memory"); __builtin_amdgcn_s_barrier(); asm volatile("" ::: "memory");
#pragma unroll
        for (int n = 0; n < 2; ++n) {
            if (n == 1) { wq[0] = *(const f32x4*)(cw + ch0 + 4); wq[1] = *(const f32x4*)(cw + 5632 + ch0 + 4); wq[2] = *(const f32x4*)(cw + 2 * 5632 + ch0 + 4); wq[3] = *(const f32x4*)(cb + ch0 + 4);
                          wq[4] = *(const f32x4*)(cw + FFD + ch0 + 4); wq[5] = *(const f32x4*)(cw + 5632 + FFD + ch0 + 4); wq[6] = *(const f32x4*)(cw + 2 * 5632 + FFD + ch0 + 4); wq[7] = *(const f32x4*)(cb + FFD + ch0 + 4); }
#pragma unroll
            for (int ai = 0; ai < 2; ++ai) {
                const int pblk = ai * 2 + wr - 1;
                float outv[4][4];
                {
                const f32x4 w0g = wq[0], w1g = wq[1], w2g = wq[2], bg = wq[3];
                f32x4 p2g, p3g;
#pragma unroll
                for (int e = 0; e < 4; ++e) { p2g[e] = prev_lane16(acc[ai][0][2][n][e]); p3g[e] = prev_lane16(acc[ai][0][3][n][e]); }
                if (fr == 0) { if (pblk >= 0) { const float* bp = bnd + (pblk * 2) * 256 + wc * 32 + 8 * fq + 4 * n; p2g = *(const f32x4*)(bp); p3g = *(const f32x4*)(bp + 256); } else { p2g = (f32x4){0.f, 0.f, 0.f, 0.f}; p3g = p2g; } }
                const f32x4 g0 = acc[ai][0][0][n], g1 = acc[ai][0][1][n], g2 = acc[ai][0][2][n], g3 = acc[ai][0][3][n];
                const f32x4 cg0 = bg + w2g * g0 + w1g * p3g + w0g * p2g, cg1 = bg + w2g * g1 + w1g * g0 + w0g * p3g, cg2 = bg + w2g * g2 + w1g * g1 + w0g * g0, cg3 = bg + w2g * g3 + w1g * g2 + w0g * g1;
#pragma unroll
                for (int e = 0; e < 4; ++e) { outv[0][e] = fast_silu(cg0[e]); outv[1][e] = fast_silu(cg1[e]); outv[2][e] = fast_silu(cg2[e]); outv[3][e] = fast_silu(cg3[e]); }
                }
                {
                const f32x4 w0v = wq[4], w1v = wq[5], w2v = wq[6], bv = wq[7];
                f32x4 p2v, p3v;
#pragma unroll
                for (int e = 0; e < 4; ++e) { p2v[e] = prev_lane16(acc[ai][1][2][n][e]); p3v[e] = prev_lane16(acc[ai][1][3][n][e]); }
                if (fr == 0) { if (pblk >= 0) { const float* bp = bnd + (pblk * 2) * 256 + HALF + wc * 32 + 8 * fq + 4 * n; p2v = *(const f32x4*)(bp); p3v = *(const f32x4*)(bp + 256); } else { p2v = (f32x4){0.f, 0.f, 0.f, 0.f}; p3v = p2v; } }
                const f32x4 v0 = acc[ai][1][0][n], v1 = acc[ai][1][1][n], v2 = acc[ai][1][2][n], v3 = acc[ai][1][3][n];
                const f32x4 cv0 = bv + w2v * v0 + w1v * p3v + w0v * p2v, cv1 = bv + w2v * v1 + w1v * v0 + w0v * p3v, cv2 = bv + w2v * v2 + w1v * v1 + w0v * v0, cv3 = bv + w2v * v3 + w1v * v2 + w0v * v1;
#pragma unroll
                for (int e = 0; e < 4; ++e) { outv[0][e] *= cv0[e]; outv[1][e] *= cv1[e]; outv[2][e] *= cv2[e]; outv[3][e] *= cv3[e]; }
                }
#pragma unroll
                for (int m = 0; m < 4; ++m) { const int tau = ai * HALF + wr * 64 + 4 * fr + m;
                    if (tau >= 2 || ii == 0) { u32x2 w; w.x = cvt_pk_bf16(outv[m][0], outv[m][1]); w.y = cvt_pk_bf16(outv[m][2], outv[m][3]);
                        *(u32x2*)(act + ((size_t)((ch0 + 4 * n) >> 6) * NTOK + (rowbase + tau)) * 64 + ((ch0 + 4 * n) & 63)) = w; } }
            }
        }
    }
};

template <class Epi>
__device__ __forceinline__ void gemm_phase(unsigned char* lds_g, const bf16_t* Ag, const bf16_t* Btg, int lda, int K, const Sched& S, const Epi& E, int tid, size_t kstepA = 128) {
    LAS unsigned char* lds = (LAS unsigned char*)lds_g;
    const int wid = __builtin_amdgcn_readfirstlane(tid >> 6), lane = tid & 63, wr = wid >> 2, wc = wid & 3, fr = lane & 15, fq = lane >> 4;
    const int nt = K / BK;
    unsigned voffA[2], voffB[2];
#pragma unroll
    for (int i = 0; i < 2; ++i) { int R, C; stage_rc(tid * 16 + i * 8192, R, C);
        const int Rb = Epi::PERM ? ((R & ~31) + perm32(R & 31)) : R;
        const int Ra = Epi::APERM ? ((R & 64) + 4 * (R & 15) + ((R >> 4) & 3)) : R;
        voffA[i] = (unsigned)(Ra * lda + C) * 2u; voffB[i] = (unsigned)(Rb * K + C) * 2u; }
    const size_t kstep = (size_t)(BK * 2);
    const size_t hstepA = (size_t)HALF * lda * 2, hstepB = (size_t)HALF * K * 2;
    const unsigned ldsw = (unsigned)wid * 1024u;
    const int aoff = lds_byte(wr * 64 + fr, fq * 8), boff = lds_byte(wc * 32 + fr, fq * 8);
#define PG8_SA(b, h) (((b) * 2 + (h)) * HTB)
#define PG8_SB(b, h) ((4 + (b) * 2 + (h)) * HTB)
#define PG8_STAGE(bufoff, gbase, voff) do { _Pragma("unroll") for (int _i = 0; _i < 2; ++_i) \
        __builtin_amdgcn_global_load_lds((const unsigned*)((const char*)(gbase) + (voff)[_i]), (LAS unsigned*)(lds + (bufoff) + ldsw + _i * 8192), 16, 0, 0); } while (0)
#define PG8_LDA(dst, b, h) do { _Pragma("unroll") for (int m = 0; m < 4; ++m) _Pragma("unroll") for (int k = 0; k < 2; ++k) dst[m][k] = *(const LAS bf16x8*)(lds + PG8_SA(b, h) + aoff + m * 2048 + k * 1024); } while (0)
#define PG8_LDB(dst, b, h) do { _Pragma("unroll") for (int n = 0; n < 2; ++n) _Pragma("unroll") for (int k = 0; k < 2; ++k) dst[n][k] = *(const LAS bf16x8*)(lds + PG8_SB(b, h) + boff + n * 2048 + k * 1024); } while (0)
#define PG8_MMA(ai, bj, At, Bt) do { __builtin_amdgcn_s_setprio(1); _Pragma("unroll") for (int m = 0; m < 4; ++m) _Pragma("unroll") for (int n = 0; n < 2; ++n) _Pragma("unroll") for (int k = 0; k < 2; ++k) \
        acc[ai][bj][m][n] = __builtin_amdgcn_mfma_f32_16x16x32_bf16(Bt[n][k], At[m][k], acc[ai][bj][m][n], 0, 0, 0); __builtin_amdgcn_s_setprio(0); } while (0)
#define PG8_WAIT_V(n) asm volatile("s_waitcnt vmcnt(" #n ")" ::: "memory")
#define PG8_WAIT_L(n) asm volatile("s_waitcnt lgkmcnt(" #n ")" ::: "memory")
#define PG8_BAR __builtin_amdgcn_s_barrier()
#define PG8_SCHED __builtin_amdgcn_sched_barrier(0)
    Unit cur, nxt; int ui = 0;
    if (!S.next(0, cur)) return;
    f32x4 acc[2][2][4][2];
#pragma unroll
    for (int a = 0; a < 2; ++a)
#pragma unroll
        for (int b = 0; b < 2; ++b)
#pragma unroll
            for (int m = 0; m < 4; ++m)
#pragma unroll
                for (int n = 0; n < 2; ++n) acc[a][b][m][n] = (f32x4){0.f, 0.f, 0.f, 0.f};
    bf16x8 At[4][2], B0[2][2], B1[2][2];
    const char* cA = (const char*)Ag + cur.a_off; const char* cB = (const char*)Btg + cur.b_off;
    PG8_STAGE(PG8_SB(0, 0), cB, voffB); PG8_STAGE(PG8_SB(0, 1), cB + hstepB, voffB); PG8_STAGE(PG8_SA(0, 0), cA, voffA); PG8_STAGE(PG8_SA(0, 1), cA + hstepA, voffA);
    if (wr == 1) PG8_BAR;
    PG8_WAIT_V(2); PG8_BAR;
    PG8_STAGE(PG8_SB(1, 0), cB + kstep, voffB); PG8_STAGE(PG8_SA(1, 0), cA + kstepA, voffA); PG8_STAGE(PG8_SB(1, 1), cB + hstepB + kstep, voffB);
    PG8_WAIT_V(6); PG8_BAR;
    for (;;) {
        const bool narrow = E.narrow(cur);
        const bool has_next = S.next(ui + 1, nxt);
        const char* nA = has_next ? (const char*)Ag + nxt.a_off : cA; const char* nB = has_next ? (const char*)Btg + nxt.b_off : cB;
        for (int t = 0; t < nt; t += 2) {
            const bool last = (t == nt - 2);
            const char* a1 = cA + (size_t)(t + 1) * kstepA;
            const char* a2 = last ? nA : cA + (size_t)(t + 2) * kstepA; const char* b2 = last ? nB : cB + (size_t)(t + 2) * kstep;
            const char* a3 = a2 + kstepA; const char* b3 = b2 + kstep;
            PG8_LDB(B0, 0, 0); PG8_LDB(B1, 0, 1); PG8_SCHED; PG8_LDA(At, 0, 0); PG8_STAGE(PG8_SA(1, 1), a1 + hstepA, voffA);
            PG8_WAIT_V(8); PG8_WAIT_L(0); PG8_BAR; PG8_MMA(0, 0, At, B0); if (!narrow) PG8_MMA(0, 1, At, B1); PG8_BAR; PG8_SCHED;
            PG8_LDA(At, 0, 1); PG8_STAGE(PG8_SB(0, 0), b2, voffB); PG8_STAGE(PG8_SB(0, 1), b2 + hstepB, voffB); PG8_STAGE(PG8_SA(0, 0), a2, voffA);
            PG8_WAIT_V(8); PG8_WAIT_L(0); PG8_BAR; PG8_MMA(1, 0, At, B0); if (!narrow) PG8_MMA(1, 1, At, B1); PG8_BAR; PG8_SCHED;
            PG8_LDB(B0, 1, 0); PG8_LDB(B1, 1, 1); PG8_SCHED; PG8_LDA(At, 1, 0); PG8_STAGE(PG8_SA(0, 1), a2 + hstepA, voffA);
            PG8_WAIT_V(8); PG8_WAIT_L(0); PG8_BAR; PG8_MMA(0, 0, At, B0); if (!narrow) PG8_MMA(0, 1, At, B1); PG8_BAR; PG8_SCHED;
            PG8_LDA(At, 1, 1); PG8_STAGE(PG8_SB(1, 0), b3, voffB); PG8_STAGE(PG8_SB(1, 1), b3 + hstepB, voffB); PG8_STAGE(PG8_SA(1, 0), a3, voffA);
            PG8_WAIT_V(8); PG8_WAIT_L(0); PG8_BAR; PG8_MMA(1, 0, At, B0); if (!narrow) PG8_MMA(1, 1, At, B1); PG8_BAR; PG8_SCHED;
        }
        if (wr == 0) PG8_BAR;
        E(acc, cur, wr, wc, fr, fq, lds_g);
        if (!has_next) break;
#pragma unroll
        for (int a = 0; a < 2; ++a)
#pragma unroll
            for (int b = 0; b < 2; ++b)
#pragma unroll
                for (int m = 0; m < 4; ++m)
#pragma unroll
                    for (int n = 0; n < 2; ++n) acc[a][b][m][n] = (f32x4){0.f, 0.f, 0.f, 0.f};
        cur = nxt; cA = nA; cB = nB; ++ui;
        if (wr == 1) PG8_BAR;
    }
    PG8_WAIT_V(0);
    PG8_BAR;
#undef PG8_SA
#undef PG8_SB
#undef PG8_STAGE
#undef PG8_LDA
#undef PG8_LDB
#undef PG8_MMA
#undef PG8_WAIT_V
#undef PG8_WAIT_L
#undef PG8_BAR
#undef PG8_SCHED
}
}

struct Params { const float* in[26]; float* out; unsigned char* ws; };
enum { I_X = 0, I_MIXNW, I_FFNNW, I_FINNW, I_GLA_WIN, I_GLA_WG2, I_GLA_BG, I_GLA_NW, I_GLA_WOUT, I_POOL_W, I_POOL_B, I_POOL_SC,
       I_SSD_WIN, I_SSD_CW, I_SSD_CB, I_SSD_DTB, I_SSD_ALOG, I_SSD_D, I_SSD_NW, I_SSD_WOUT, I_SB_WQKV, I_SB_WOUT, I_FFN_WUP, I_FFN_CW, I_FFN_CB, I_FFN_WDOWN };

struct TrItem { const float* W; int K, N; bf16_t* dst; int drow, n0, k0; const float* ks; float cs; };
__device__ __forceinline__ void tr_load(const TrItem& t, float (&v)[64], int lane) {
    const int n = t.n0 + lane; const bool ok = n < t.N;
#pragma unroll
    for (int kk = 0; kk < 64; ++kk) v[kk] = ok ? __builtin_nontemporal_load(t.W + (size_t)(t.k0 + kk) * t.N + n) : 0.f;
}
__device__ __forceinline__ void tr_store(const TrItem& t, const float (&v)[64], float* scr, int lane) {
#pragma unroll
    for (int kk = 0; kk < 64; ++kk) { float x = v[kk]; if (t.ks) x *= t.ks[t.k0 + kk]; scr[kk * 65 + lane] = x * t.cs; }
    asm volatile("s_waitcnt lgkmcnt(0)" ::: "memory");
    const int c = lane & 7;
#pragma unroll
    for (int j = 0; j < 8; ++j) { const int nn = (lane >> 3) + 8 * j; const float* s = scr + (8 * c) * 65 + nn;
        u32x4 o; o.x = cvt_pk_bf16(s[0], s[65]); o.y = cvt_pk_bf16(s[2 * 65], s[3 * 65]); o.z = cvt_pk_bf16(s[4 * 65], s[5 * 65]); o.w = cvt_pk_bf16(s[6 * 65], s[7 * 65]);
        *(u32x4*)(t.dst + (size_t)(t.drow + nn) * t.K + t.k0 + 8 * c) = o; }
    asm volatile("s_waitcnt lgkmcnt(0)" ::: "memory");
}
constexpr int I_UP = 16 * 88, I_DOWN = 44 * 16, I_GIN = 16 * 52, I_SQ = 16 * 16, I_POOLG = 4 * 4, I_SIN = 16 * 84, I_SOUT = 32 * 16, I_QKV = 16 * 48;
constexpr int NITEMS = 4 * I_UP + 4 * I_DOWN + I_GIN + I_SQ + 4 * I_POOLG + I_SIN + I_SOUT + I_QKV + I_SQ;
__device__ __forceinline__ TrItem tr_desc(const Params& p, int it) {
    unsigned char* ws = p.ws; int r = it;
    if (r < 4 * I_UP) { const int l = r / I_UP; r -= l * I_UP; const int kb = r / 88, nb = r % 88; const int n0 = nb * 64; const int half = n0 / FFD, cidx = n0 - half * FFD; const int drow = (cidx >> 7) * 256 + half * 128 + (cidx & 127);
        return TrItem{p.in[I_FFN_WUP] + (size_t)l * 1024 * 5632, 1024, 5632, (bf16_t*)(ws + WS_W + l * W_FFN_STRIDE), drow, n0, kb * 64, p.in[I_FFNNW] + l * 1024, 1.f}; } r -= 4 * I_UP;
    if (r < 4 * I_DOWN) { const int l = r / I_DOWN; r -= l * I_DOWN; const int kb = r / 16, nb = r % 16;
        return TrItem{p.in[I_FFN_WDOWN] + (size_t)l * FFD * 1024, FFD, 1024, (bf16_t*)(ws + WS_W + l * W_FFN_STRIDE + W_FFN_DOWN_OFF), nb * 64, nb * 64, kb * 64, nullptr, 1.f}; } r -= 4 * I_DOWN;
    if (r < I_GIN) { const int kb = r / 52, nb = r % 52; const int n0 = nb * 64;
        return TrItem{p.in[I_GLA_WIN], 1024, 3088, (bf16_t*)(ws + W_GLA_IN), n0, n0, kb * 64, p.in[I_MIXNW], n0 < 512 ? 0.08838834764831845f : 1.f}; } r -= I_GIN;
    if (r < I_SQ) { const int kb = r / 16, nb = r % 16;
        return TrItem{p.in[I_GLA_WOUT], 1024, 1024, (bf16_t*)(ws + W_GLA_OUT), nb * 64, nb * 64, kb * 64, nullptr, 1.f}; } r -= I_SQ;
    if (r < 4 * I_POOLG) { const int g = r / I_POOLG; r -= g * I_POOLG; const int kb = r / 4, nb = r % 4;
        return TrItem{p.in[I_POOL_W] + (size_t)g * 65536, 256, 256, (bf16_t*)(ws + W_POOL) + (size_t)g * 65536, nb * 64, nb * 64, kb * 64, nullptr, 1.f}; } r -= 4 * I_POOLG;
    if (r < I_SIN) { const int kb = r / 84, nb = r % 84; const int n0 = nb * 64;
        return TrItem{p.in[I_SSD_WIN], 1024, 5152, (bf16_t*)(ws + W_SSD_IN), n0, n0, kb * 64, p.in[I_MIXNW] + 2 * 1024, 1.f}; } r -= I_SIN;
    if (r < I_SOUT) { const int kb = r / 16, nb = r % 16;
        return TrItem{p.in[I_SSD_WOUT], 2048, 1024, (bf16_t*)(ws + W_SSD_OUT), nb * 64, nb * 64, kb * 64, p.in[I_SSD_NW], 1.f}; } r -= I_SOUT;
    if (r < I_QKV) { const int kb = r / 48, nb = r % 48; const int n0 = nb * 64;
        return TrItem{p.in[I_SB_WQKV], 1024, 3072, (bf16_t*)(ws + W_SB_QKV), n0, n0, kb * 64, p.in[I_MIXNW] + 3 * 1024, n0 < 1024 ? 0.125f * 1.4426950408889634f : 1.f}; } r -= I_QKV;
    { const int kb = r / 16, nb = r % 16;
        return TrItem{p.in[I_SB_WOUT], 1024, 1024, (bf16_t*)(ws + W_SB_OUT), nb * 64, nb * 64, kb * 64, nullptr, 1.f}; }
}

__device__ __forceinline__ void prep_phase(const Params& p, unsigned char* lds, int gw, int NGW, int wave, int lane) {
    float* scr = (float*)(lds + wave * 16640);
    unsigned char* ws = p.ws;
    for (int it = gw; it < NITEMS; it += 2 * NGW) {
        const TrItem ta = tr_desc(p, it); const bool hasb = (it + NGW) < NITEMS; const TrItem tb = tr_desc(p, hasb ? it + NGW : it);
        float va[64], vb[64];
        tr_load(ta, va, lane); if (hasb) tr_load(tb, vb, lane);
        tr_store(ta, va, scr, lane); if (hasb) tr_store(tb, vb, scr, lane);
    }
    const float* x = p.in[I_X]; bf16_t* XB = (bf16_t*)(ws + WS_XB); float* rssp = (float*)(ws + WS_RSSP);
    for (int m0 = gw * 4; m0 < NTOK; m0 += NGW * 4) {
        f32x4 v[4][4];
#pragma unroll
        for (int r = 0; r < 4; ++r)
#pragma unroll
            for (int j = 0; j < 4; ++j) v[r][j] = __builtin_nontemporal_load((const f32x4*)(x + (size_t)(m0 + r) * DM) + lane + 64 * j);
#pragma unroll
        for (int r = 0; r < 4; ++r) { float s = 0.f; unsigned long long* o8 = (unsigned long long*)(XB + (size_t)(m0 + r) * DM) + lane;
#pragma unroll
            for (int j = 0; j < 4; ++j) { const f32x4 t = v[r][j]; s += (t.x * t.x + t.y * t.y) + (t.z * t.z + t.w * t.w);
                o8[64 * j] = (unsigned long long)cvt_pk_bf16(t.x, t.y) | ((unsigned long long)cvt_pk_bf16(t.z, t.w) << 32); }
            s += __shfl_xor(s, 1); s += __shfl_xor(s, 2); s += __shfl_xor(s, 4); s += __shfl_xor(s, 8);
            if ((lane & 15) == 0) rssp[(size_t)(m0 + r) * 4 + (lane >> 4)] = s; }
    }
}

__device__ __forceinline__ void gla1_phase(const Params& p, unsigned char* lds, int bid, int G, int tid) {
    unsigned char* ws = p.ws;
    const bf16_t* P = (const bf16_t*)(ws + WS_BIG); const float* GLR = (const float*)(ws + WS_BIG + BIG_GLA_GLR);
    bf16_t* KDT = (bf16_t*)(ws + WS_BIG + BIG_GLA_KDT); float* EG = (float*)(ws + WS_BIG + BIG_GLA_EG); bf16_t* VT = (bf16_t*)p.out;
    float* glr_s = (float*)lds;
    float* wg_s = (float*)(lds + 4096);
    float* bg_s = (float*)(lds + 12288);
    float* tot_s = (float*)(lds + 12800);
    unsigned char* vt_s = lds + 16384;
    const float* wg2 = p.in[I_GLA_WG2]; const float* bgate = p.in[I_GLA_BG];
    for (int it = bid; it < 2048; it += G) {
        const int h = it & 3, c = (it >> 2) & 63, b = it >> 8; const int row0 = b * SEQL + c * 64;
        __syncthreads();
        for (int e = tid; e < 1024; e += 512) glr_s[e] = GLR[(size_t)(row0 + (e >> 4)) * 16 + (e & 15)];
        for (int e = tid; e < 2048; e += 512) wg_s[e] = wg2[(e >> 7) * 512 + h * 128 + (e & 127)];
        if (tid < 128) bg_s[tid] = bgate[h * 128 + tid];
        for (int e = tid; e < 2048; e += 512) { const int s = e >> 5, part = e & 31; *(u32x4*)(vt_s + s * 528 + part * 16) = *(const u32x4*)(P + (size_t)(row0 + s) * 3072 + 1024 + h * 256 + part * 8); }
        __syncthreads();
        const int k = tid & 127, sg = tid >> 7;
        float w[16];
#pragma unroll
        for (int j = 0; j < 16; ++j) w[j] = wg_s[j * 128 + k];
        const float bgk = bg_s[k];
        float gl[16]; float run = 0.f;
#pragma unroll
        for (int i = 0; i < 16; ++i) { const float* gr = glr_s + (sg * 16 + i) * 16; float pre = bgk;
#pragma unroll
            for (int j = 0; j < 16; ++j) pre += gr[j] * w[j];
            const float ls = fminf(pre, 0.f) - log1pf(expf(-fabsf(pre)));
            run += ls * (1.0f / 16.0f); gl[i] = run; }
        tot_s[sg * 128 + k] = run;
        __syncthreads();
        float off = 0.f, gend = 0.f;
#pragma unroll
        for (int g2 = 0; g2 < 4; ++g2) { const float tv = tot_s[g2 * 128 + k]; if (g2 < sg) off += tv; gend += tv; }
        unsigned pk[8];
#pragma unroll
        for (int i = 0; i < 16; i += 2) {
            const float k0 = bf1(P[(size_t)(row0 + sg * 16 + i) * 3072 + 512 + h * 128 + k]) * expf(gend - (off + gl[i]));
            const float k1 = bf1(P[(size_t)(row0 + sg * 16 + i + 1) * 3072 + 512 + h * 128 + k]) * expf(gend - (off + gl[i + 1]));
            pk[i >> 1] = cvt_pk_bf16(k0, k1); }
        u32x4* kd = (u32x4*)(KDT + (size_t)it * 8192 + k * 64 + sg * 16);
        kd[0] = (u32x4){pk[0], pk[1], pk[2], pk[3]}; kd[1] = (u32x4){pk[4], pk[5], pk[6], pk[7]};
        if (sg == 0) EG[(size_t)it * 128 + k] = expf(gend);
        { const int v = tid & 255, sh = tid >> 8; unsigned q[16];
#pragma unroll
            for (int i = 0; i < 16; ++i) { const unsigned lo = *(const bf16_t*)(vt_s + (sh * 32 + 2 * i) * 528 + v * 2), hi = *(const bf16_t*)(vt_s + (sh * 32 + 2 * i + 1) * 528 + v * 2); q[i] = lo | (hi << 16); }
            u32x4* vo = (u32x4*)(VT + (size_t)it * 16384 + v * 64 + sh * 32);
            vo[0] = (u32x4){q[0], q[1], q[2], q[3]}; vo[1] = (u32x4){q[4], q[5], q[6], q[7]}; vo[2] = (u32x4){q[8], q[9], q[10], q[11]}; vo[3] = (u32x4){q[12], q[13], q[14], q[15]}; }
    }
}

constexpr size_t BIG_GLA_SLOC = 292 * MiB, BIG_GLA_DSEG = 291 * MiB;
__device__ __forceinline__ void gla_scan_phase(const Params& p, unsigned char* lds, int bid, int G, int tid, int wave, int lane, const int MODE) {
    unsigned char* ws = p.ws;
    const bf16_t* P = (const bf16_t*)(ws + WS_BIG);
    const bf16_t* KDT = (const bf16_t*)(ws + WS_BIG + BIG_GLA_KDT); const float* EG = (const float*)(ws + WS_BIG + BIG_GLA_EG); const bf16_t* VT = (const bf16_t*)p.out;
    bf16_t* OPRE = (bf16_t*)(ws + WS_BIG + BIG_GLA_OPRE); float* SLOC = (float*)(ws + WS_BIG + BIG_GLA_SLOC); float* DSEG = (float*)(ws + WS_BIG + BIG_GLA_DSEG);
    unsigned char* KD = lds;
    unsigned char* VTs = lds + 18432;
    unsigned char* Qs = lds + 55296;
    unsigned char* ST = lds + 72704;
    float* eg_s = (float*)(lds + 142336);
    const int fr = lane & 15, fq = lane >> 4;
    for (int u = bid; u < 256; u += G) {
        const int seg = u & 7, bh = u >> 3, b = bh >> 2, h = bh & 3;
        if (MODE == 1 && seg == 7) continue;
        f32x4 S[16]; f32x4 dprod = (f32x4){1.f, 1.f, 1.f, 1.f};
        float* sl = SLOC + (size_t)u * 32768;
#pragma unroll
        for (int j = 0; j < 16; ++j) { if (MODE == 2) S[j] = *(const f32x4*)(sl + (16 * j + fr) * 128 + 16 * wave + 4 * fq); else S[j] = (f32x4){0.f, 0.f, 0.f, 0.f}; }
        u32x4 pk[2], pv[4], pq[2]; float peg = 0.f;
#define GLA_LOAD(cc) do { const int it_ = (b * 64 + (cc)) * 4 + h; const int r0_ = b * SEQL + (cc) * 64; \
            _Pragma("unroll") for (int i_ = 0; i_ < 2; ++i_) pk[i_] = *(const u32x4*)(KDT + (size_t)it_ * 8192 + (tid + 512 * i_) * 8); \
            _Pragma("unroll") for (int i_ = 0; i_ < 4; ++i_) pv[i_] = *(const u32x4*)(VT + (size_t)it_ * 16384 + (tid + 512 * i_) * 8); \
            if (MODE == 2) { _Pragma("unroll") for (int i_ = 0; i_ < 2; ++i_) { const int e_ = tid + 512 * i_; pq[i_] = *(const u32x4*)(P + (size_t)(r0_ + (e_ >> 4)) * 3072 + h * 128 + (e_ & 15) * 8); } } \
            if (tid < 128) peg = EG[(size_t)it_ * 128 + tid]; } while (0)
        GLA_LOAD(seg * 8);
        for (int c = seg * 8; c < seg * 8 + 8; ++c) {
            const int row0 = b * SEQL + c * 64;
            LBAR();
#pragma unroll
            for (int i = 0; i < 2; ++i) { const int e = tid + 512 * i; *(u32x4*)(KD + (e >> 3) * 144 + (e & 7) * 16) = pk[i]; }
#pragma unroll
            for (int i = 0; i < 4; ++i) { const int e = tid + 512 * i; *(u32x4*)(VTs + (e >> 3) * 144 + (e & 7) * 16) = pv[i]; }
            if (MODE == 2) {
#pragma unroll
                for (int i = 0; i < 2; ++i) { const int e = tid + 512 * i; *(u32x4*)(Qs + (e >> 4) * 272 + (e & 15) * 16) = pq[i]; } }
            if (tid < 128) eg_s[tid] = peg;
            if (c + 1 < seg * 8 + 8) GLA_LOAD(c + 1);
            LBAR();
            { const f32x4 ev = *(const f32x4*)(eg_s + 16 * wave + 4 * fq); dprod = dprod * ev;
              const bf16x8 a0 = ldsfrag(KD + (16 * wave + fr) * 144 + fq * 16), a1 = ldsfrag(KD + (16 * wave + fr) * 144 + 64 + fq * 16);
#pragma unroll
              for (int j4 = 0; j4 < 16; j4 += 4) { bf16x8 vb0[4], vb1[4];
#pragma unroll
                  for (int jj = 0; jj < 4; ++jj) { vb0[jj] = ldsfrag(VTs + (16 * (j4 + jj) + fr) * 144 + fq * 16); vb1[jj] = ldsfrag(VTs + (16 * (j4 + jj) + fr) * 144 + 64 + fq * 16); }
#pragma unroll
                  for (int jj = 0; jj < 4; ++jj) S[j4 + jj] = S[j4 + jj] * ev;
#pragma unroll
                  for (int jj = 0; jj < 4; ++jj) S[j4 + jj] = MFMA16(a0, vb0[jj], S[j4 + jj]);
#pragma unroll
                  for (int jj = 0; jj < 4; ++jj) S[j4 + jj] = MFMA16(a1, vb1[jj], S[j4 + jj]);
                  if (MODE == 2) {
#pragma unroll
                      for (int jj = 0; jj < 4; ++jj) { const int j = j4 + jj; u32x2 w; w.x = cvt_pk_bf16(S[j][0], S[j][1]); w.y = cvt_pk_bf16(S[j][2], S[j][3]);
                          *(u32x2*)(ST + (16 * j + fr) * 272 + (16 * wave + 4 * fq) * 2) = w; } } } }
            if (MODE == 2) {
            LBAR();
            f32x4 o[2][4];
#pragma unroll
            for (int jj = 0; jj < 2; ++jj)
#pragma unroll
                for (int tt = 0; tt < 4; ++tt) o[jj][tt] = (f32x4){0.f, 0.f, 0.f, 0.f};
#pragma unroll
            for (int ks = 0; ks < 4; ++ks) {
                bf16x8 av[2], bq[4];
#pragma unroll
                for (int jj = 0; jj < 2; ++jj) av[jj] = ldsfrag(ST + (16 * (2 * wave + jj) + fr) * 272 + ks * 64 + fq * 16);
#pragma unroll
                for (int tt = 0; tt < 4; ++tt) bq[tt] = ldsfrag(Qs + (16 * tt + fr) * 272 + ks * 64 + fq * 16);
#pragma unroll
                for (int jj = 0; jj < 2; ++jj)
#pragma unroll
                    for (int tt = 0; tt < 4; ++tt) o[jj][tt] = MFMA16(av[jj], bq[tt], o[jj][tt]);
            }
#pragma unroll
            for (int jj = 0; jj < 2; ++jj)
#pragma unroll
                for (int tt = 0; tt < 4; ++tt) { u32x2 w; w.x = cvt_pk_bf16(o[jj][tt][0], o[jj][tt][1]); w.y = cvt_pk_bf16(o[jj][tt][2], o[jj][tt][3]);
                    *(u32x2*)(OPRE + (size_t)(row0 + 16 * tt + fr) * DM + h * 256 + 16 * (2 * wave + jj) + 4 * fq) = w; }
            }
        }
        if (MODE == 1) {
#pragma unroll
            for (int j = 0; j < 16; ++j) *(f32x4*)(sl + (16 * j + fr) * 128 + 16 * wave + 4 * fq) = S[j];
            if (fr == 0) *(f32x4*)(DSEG + (size_t)u * 128 + 16 * wave + 4 * fq) = dprod;
        }
    }
#undef GLA_LOAD
}
__device__ __forceinline__ void gla_combine_phase(const Params& p, int bid, int G, int tid) {
    float* SLOC = (float*)(p.ws + WS_BIG + BIG_GLA_SLOC); const float* DSEG = (const float*)(p.ws + WS_BIG + BIG_GLA_DSEG);
    for (int idx = bid * 512 + tid; idx < 32 * 8192; idx += G * 512) { const int bh = idx >> 13, e = (idx & 8191) * 4, k0 = e & 127;
        f32x4 prev = (f32x4){0.f, 0.f, 0.f, 0.f};
#pragma unroll
        for (int seg = 0; seg < 8; ++seg) { const int u = bh * 8 + seg; f32x4* q = (f32x4*)(SLOC + (size_t)u * 32768 + e);
            f32x4 loc = (f32x4){0.f, 0.f, 0.f, 0.f}, d = (f32x4){0.f, 0.f, 0.f, 0.f};
            if (seg < 7) { loc = *q; d = *(const f32x4*)(DSEG + (size_t)u * 128 + k0); }
            *q = prev; prev = loc + d * prev; } }
}

__device__ __forceinline__ void gla3_phase(const Params& p, int gw, int NGW, int lane) {
    unsigned char* ws = p.ws;
    const bf16_t* P = (const bf16_t*)(ws + WS_BIG); bf16_t* OPRE = (bf16_t*)(ws + WS_BIG + BIG_GLA_OPRE);
    const float* nw = p.in[I_GLA_NW] + 16 * lane;
    float nwv[16];
#pragma unroll
    for (int i = 0; i < 16; ++i) nwv[i] = nw[i];
    for (int m = gw; m < NTOK; m += NGW) {
        u32x4* op = (u32x4*)(OPRE + (size_t)m * DM + 16 * lane); const u32x4* rp = (const u32x4*)(P + (size_t)m * 3072 + 2048 + 16 * lane);
        const u32x4 o0 = op[0], o1 = op[1], r0 = __builtin_nontemporal_load(rp), r1 = __builtin_nontemporal_load(rp + 1);
        float ov[16], rv[16];
#pragma unroll
        for (int i = 0; i < 4; ++i) { ov[2 * i] = bflo(o0[i]); ov[2 * i + 1] = bfhi(o0[i]); ov[8 + 2 * i] = bflo(o1[i]); ov[8 + 2 * i + 1] = bfhi(o1[i]);
            rv[2 * i] = bflo(r0[i]); rv[2 * i + 1] = bfhi(r0[i]); rv[8 + 2 * i] = bflo(r1[i]); rv[8 + 2 * i + 1] = bfhi(r1[i]); }
        float ss = 0.f;
#pragma unroll
        for (int i = 0; i < 16; ++i) ss += ov[i] * ov[i];
        ss += __shfl_xor(ss, 1); ss += __shfl_xor(ss, 2); ss += __shfl_xor(ss, 4); ss += __shfl_xor(ss, 8);
        const float rstd = rsqrtf(ss * (1.0f / 256.0f) + 1e-6f);
        float res[16];
#pragma unroll
        for (int i = 0; i < 16; ++i) res[i] = ov[i] * rstd * nwv[i] * fast_silu(rv[i]);
        u32x4 w0, w1;
#pragma unroll
        for (int i = 0; i < 4; ++i) { w0[i] = cvt_pk_bf16(res[2 * i], res[2 * i + 1]); w1[i] = cvt_pk_bf16(res[8 + 2 * i], res[8 + 2 * i + 1]); }
        op[0] = w0; op[1] = w1;
    }
}

__device__ __forceinline__ void pool_dlt_phase(const Params& p, unsigned char* lds, int bid, int G, int tid) {
    unsigned char* ws = p.ws;
    const bf16_t* X = (const bf16_t*)(ws + WS_XB); const float* rssp = (const float*)(ws + WS_RSSP); bf16_t* DLT = (bf16_t*)(ws + WS_BIG);
    float* rs_s = (float*)lds;
    const int c = 2 * tid; const int win = 2 << (c >> 8);
    const float w0 = p.in[I_MIXNW][1024 + c], w1 = p.in[I_MIXNW][1024 + c + 1];
    for (int u = bid; u < 512; u += G) {
        const int b = u >> 6, t0 = (u & 63) * 64;
        __syncthreads();
        if (tid < 79) { const int j = t0 - 15 + tid; rs_s[tid] = j >= 0 ? row_rstd(rssp, b * SEQL + j) : 0.f; }
        __syncthreads();
        float s0 = 0.f, s1 = 0.f;
        for (int j = t0 - win + 1; j < t0; ++j) if (j >= 0) { const unsigned xv = *(const unsigned*)(X + (size_t)(b * SEQL + j) * DM + c); const float r = rs_s[j - t0 + 15]; s0 += bflo(xv) * r * w0; s1 += bfhi(xv) * r * w1; }
#pragma unroll 8
        for (int t = t0; t < t0 + 64; ++t) {
            const unsigned xv = *(const unsigned*)(X + (size_t)(b * SEQL + t) * DM + c); const float r = rs_s[t - t0 + 15];
            const float h0 = bflo(xv) * r * w0, h1 = bfhi(xv) * r * w1; s0 += h0; s1 += h1;
            const float inv = 1.0f / (float)min(t + 1, win);
            *(unsigned*)(DLT + (size_t)(b * SEQL + t) * DM + c) = cvt_pk_bf16(s0 * inv - h0, s1 * inv - h1);
            const int jo = t - win + 1;
            if (jo >= 0) { const unsigned xo = *(const unsigned*)(X + (size_t)(b * SEQL + jo) * DM + c); const float ro = rs_s[jo - t0 + 15]; s0 -= bflo(xo) * ro * w0; s1 -= bfhi(xo) * ro * w1; }
        }
    }
}

__device__ __forceinline__ float softplusf(float x) { return fmaxf(x, 0.f) + log1pf(expf(-fabsf(x))); }
constexpr size_t XBR_ACS = 0, XBR_HALO = 8 * MiB;
__device__ __forceinline__ void ssd_dt_fix_phase(const Params& p, unsigned char* lds, int bid, int G, int tid) {
    bf16_t* P = (bf16_t*)(p.ws + WS_BIG); float* DT = (float*)(p.ws + WS_BIG + BIG_SSD_DT); float* ACS = (float*)((unsigned char*)p.out + XBR_ACS);
    const float* side = (const float*)((unsigned char*)p.out + XBR_HALO);
    const float* cw = p.in[I_SSD_CW]; const float* cb = p.in[I_SSD_CB];
    float* tot_s = (float*)lds;
    for (int u = bid; u < 512; u += G) { const int b = u >> 6, c = u & 63; const int row0 = b * SEQL + c * 64;
        const int h = tid & 31, sg = tid >> 5; const float dtb = p.in[I_SSD_DTB][h], aneg = -expf(p.in[I_SSD_ALOG][h]);
        float dtv[4], ac[4]; float run = 0.f;
#pragma unroll
        for (int i = 0; i < 4; ++i) { dtv[i] = softplusf(DT[(size_t)(row0 + 4 * sg + i) * 32 + h] + dtb); run += dtv[i] * aneg; ac[i] = run; }
        __syncthreads(); tot_s[sg * 32 + h] = run; __syncthreads();
        float off = 0.f;
        for (int g2 = 0; g2 < sg; ++g2) off += tot_s[g2 * 32 + h];
#pragma unroll
        for (int i = 0; i < 4; ++i) { DT[(size_t)(row0 + 4 * sg + i) * 32 + h] = dtv[i]; ACS[(size_t)(row0 + 4 * sg + i) * 32 + h] = off + ac[i]; }
    }
    for (int idx = bid * 512 + tid; idx < 128 * 3 * 768; idx += G * 512) {
        const int q = idx % 768, r = idx / 768, tau = r % 3, pm = r / 3;
        if ((pm & 15) == 0) continue;
        const int xc = q * 4;
        const float* cur = side + (size_t)pm * 6 * 3072 + xc; const float* prv = side + (size_t)(pm - 1) * 6 * 3072 + xc;
        const f32x4 u0 = *(const f32x4*)(cur + tau * 3072);
        const f32x4 u1 = tau >= 1 ? *(const f32x4*)(cur + (tau - 1) * 3072) : *(const f32x4*)(prv + 5 * 3072);
        const f32x4 u2 = tau >= 2 ? *(const f32x4*)(cur + (tau - 2) * 3072) : *(const f32x4*)(prv + (4 + tau) * 3072);
        const f32x4 u3 = *(const f32x4*)(prv + (3 + tau) * 3072);
        const f32x4 o = *(const f32x4*)(cb + xc) + *(const f32x4*)(cw + 3 * 3072 + xc) * u0 + *(const f32x4*)(cw + 2 * 3072 + xc) * u1 + *(const f32x4*)(cw + 3072 + xc) * u2 + *(const f32x4*)(cw + xc) * u3;
        u32x2 w; w.x = cvt_pk_bf16(fast_silu(o[0]), fast_silu(o[1])); w.y = cvt_pk_bf16(fast_silu(o[2]), fast_silu(o[3]));
        *(u32x2*)(P + (size_t)(pm * 256 + tau) * 5120 + 2048 + xc) = w;
    }
}
__device__ __forceinline__ void ssd_scan_phase(const Params& p, unsigned char* lds, int bid, int G, int tid, int wave, int lane, int dry) {
    unsigned char* ws = p.ws;
    bf16_t* P = (bf16_t*)(ws + WS_BIG); const float* DT = (const float*)(ws + WS_BIG + BIG_SSD_DT); const float* ACS = (const float*)((unsigned char*)p.out + XBR_ACS);
    unsigned char* Cm = lds;
    unsigned char* Bm = lds + 17408;
    unsigned char* BdT = lds + 34816;
    unsigned char* xdtT = lds + 53248;
    unsigned char* xT = lds + 62464;
    unsigned char* Mt = lds + 71680;
    unsigned char* stB = lds + 80896;
    float* acs_s = (float*)(lds + 115712);
    const int fr = lane & 15, fq = lane >> 4;
    for (int u = bid; u < 256; u += G) {
        const int b = u >> 5, h = u & 31, g = h >> 3;
        const float dsk = p.in[I_SSD_D][h];
        f32x4 st[4];
#pragma unroll
        for (int i = 0; i < 4; ++i) st[i] = (f32x4){0.f, 0.f, 0.f, 0.f};
        LBAR();
        for (int e = tid; e < 64 * 272 / 4; e += 512) ((unsigned*)stB)[e] = 0u;
        const int sx = tid >> 3, partx = tid & 7;
        u32x4 pxA, pbA[2], pcA[2], pxB, pbB[2], pcB[2]; float pdtA, pacsbA[2], pacs_endA, pacs_tA = 0.f, pdtB, pacsbB[2], pacs_endB, pacs_tB = 0.f;
#define SSD_LOAD(S_, cc) do { const int r0_ = b * SEQL + (cc) * 64; \
            px##S_ = *(const u32x4*)(P + (size_t)(r0_ + sx) * 5120 + 2048 + h * 64 + partx * 8); pdt##S_ = DT[(size_t)(r0_ + sx) * 32 + h]; \
            _Pragma("unroll") for (int i_ = 0; i_ < 2; ++i_) { const int e_ = tid + 512 * i_; const int sb_ = e_ >> 4, pt_ = e_ & 15; \
                pb##S_[i_] = *(const u32x4*)(P + (size_t)(r0_ + sb_) * 5120 + 4096 + g * 128 + pt_ * 8); pc##S_[i_] = *(const u32x4*)(P + (size_t)(r0_ + sb_) * 5120 + 4608 + g * 128 + pt_ * 8); \
                pacsb##S_[i_] = ACS[(size_t)(r0_ + sb_) * 32 + h]; } \
            pacs_end##S_ = ACS[(size_t)(r0_ + 63) * 32 + h]; if (tid < 64) pacs_t##S_ = ACS[(size_t)(r0_ + tid) * 32 + h]; } while (0)
        SSD_LOAD(A, 0); SSD_LOAD(B, 1);
        for (int c0 = 0; c0 < 64; c0 += 2) {
          { const int c = c0;
            const int row0 = b * SEQL + c * 64;
            LBAR();
            const float acs_end = pacs_endA;
            {
#pragma unroll
                for (int j = 0; j < 4; ++j) { const unsigned w = pxA[j]; const float x0 = bflo(w), x1 = bfhi(w);
                    *(bf16_t*)(xT + swz144(partx * 8 + 2 * j, sx * 2)) = (bf16_t)(w & 0xffffu); *(bf16_t*)(xT + swz144(partx * 8 + 2 * j + 1, sx * 2)) = (bf16_t)(w >> 16);
                    const unsigned d = cvt_pk_bf16(x0 * pdtA, x1 * pdtA);
                    *(bf16_t*)(xdtT + swz144(partx * 8 + 2 * j, sx * 2)) = (bf16_t)(d & 0xffffu); *(bf16_t*)(xdtT + swz144(partx * 8 + 2 * j + 1, sx * 2)) = (bf16_t)(d >> 16); }
#pragma unroll
                for (int i = 0; i < 2; ++i) { const int e = tid + 512 * i; const int sb = e >> 4, pt = e & 15;
                    *(u32x4*)(Bm + sb * 272 + pt * 16) = pbA[i]; *(u32x4*)(Cm + sb * 272 + pt * 16) = pcA[i];
                    const float dec = __expf(acs_end - pacsbA[i]);
#pragma unroll
                    for (int j = 0; j < 4; ++j) { const unsigned w = pbA[i][j]; const unsigned d = cvt_pk_bf16(bflo(w) * dec, bfhi(w) * dec);
                        *(bf16_t*)(BdT + swz144(pt * 8 + 2 * j, sb * 2)) = (bf16_t)(d & 0xffffu); *(bf16_t*)(BdT + swz144(pt * 8 + 2 * j + 1, sb * 2)) = (bf16_t)(d >> 16); } }
                if (tid < 64) acs_s[tid] = pacs_tA;
            }
            if (c + 2 < 64) SSD_LOAD(A, c + 2);
            LBAR();
            bf16x8 c0[4], c1[4];
            { const int stl = wave >> 1; const int tt0 = (wave & 1) * 2;
              bf16x8 a[4];
#pragma unroll
              for (int ks = 0; ks < 4; ++ks) { a[ks] = ldsfrag(Bm + (16 * stl + fr) * 272 + ks * 64 + fq * 16); c0[ks] = ldsfrag(Cm + (16 * tt0 + fr) * 272 + ks * 64 + fq * 16); c1[ks] = ldsfrag(Cm + (16 * (tt0 + 1) + fr) * 272 + ks * 64 + fq * 16); }
              const f32x4 as4 = *(const f32x4*)(acs_s + 16 * stl + 4 * fq); const float at0 = acs_s[16 * tt0 + fr], at1 = acs_s[16 * tt0 + 16 + fr];
              f32x4 d0 = (f32x4){0.f, 0.f, 0.f, 0.f}, d1 = d0;
#pragma unroll
              for (int ks = 0; ks < 4; ++ks) { d0 = MFMA16(a[ks], c0[ks], d0); d1 = MFMA16(a[ks], c1[ks], d1); }
#pragma unroll
              for (int tj = 0; tj < 2; ++tj) { const int t = 16 * (tt0 + tj) + fr; const float at = tj ? at1 : at0; const f32x4 d = tj ? d1 : d0; float mv[4];
#pragma unroll
                  for (int i = 0; i < 4; ++i) { const int sidx = 16 * stl + 4 * fq + i; const float e = __expf(fminf(at - as4[i], 0.f)); mv[i] = (sidx <= t) ? d[i] * e : 0.f; }
                  u32x2 w; w.x = cvt_pk_bf16(mv[0], mv[1]); w.y = cvt_pk_bf16(mv[2], mv[3]);
                  *(u32x2*)(Mt + t * 144 + (16 * stl + 4 * fq) * 2) = w; } }
            { const float ee = __expf(acs_end);
              const bf16x8 a0 = ldsfrag(BdT + swz144(16 * wave + fr, fq * 16)), a1 = ldsfrag(BdT + swz144(16 * wave + fr, 64 + fq * 16));
              bf16x8 xb0[4], xb1[4];
#pragma unroll
              for (int pt = 0; pt < 4; ++pt) { xb0[pt] = ldsfrag(xdtT + swz144(16 * pt + fr, fq * 16)); xb1[pt] = ldsfrag(xdtT + swz144(16 * pt + fr, 64 + fq * 16)); }
#pragma unroll
              for (int pt = 0; pt < 4; ++pt) st[pt] = st[pt] * ee;
#pragma unroll
              for (int pt = 0; pt < 4; ++pt) st[pt] = MFMA16(a0, xb0[pt], st[pt]);
#pragma unroll
              for (int pt = 0; pt < 4; ++pt) st[pt] = MFMA16(a1, xb1[pt], st[pt]);
#pragma unroll
              for (int pt = 0; pt < 4; ++pt) { u32x2 w; w.x = cvt_pk_bf16(st[pt][0], st[pt][1]); w.y = cvt_pk_bf16(st[pt][2], st[pt][3]);
                  *(u32x2*)(stB + ((c + 1) & 1) * 17408 + (16 * pt + fr) * 272 + (16 * wave + 4 * fq) * 2) = w; } }
            LBAR();
            { const int pt = wave >> 1; const int tt0 = (wave & 1) * 2;
              bf16x8 ax[2], as_[4], m0[2], m1[2];
#pragma unroll
              for (int ks = 0; ks < 2; ++ks) { ax[ks] = ldsfrag(xdtT + swz144(16 * pt + fr, ks * 64 + fq * 16)); m0[ks] = ldsfrag(Mt + (16 * tt0 + fr) * 144 + ks * 64 + fq * 16); m1[ks] = ldsfrag(Mt + (16 * tt0 + 16 + fr) * 144 + ks * 64 + fq * 16); }
#pragma unroll
              for (int ks = 0; ks < 4; ++ks) as_[ks] = ldsfrag(stB + (c & 1) * 17408 + (16 * pt + fr) * 272 + ks * 64 + fq * 16);
              const float ea0 = __expf(acs_s[16 * tt0 + fr]), ea1 = __expf(acs_s[16 * tt0 + 16 + fr]);
              float xs0[4], xs1[4];
#pragma unroll
              for (int i = 0; i < 4; ++i) { const int pp = 16 * pt + 4 * fq + i; xs0[i] = bf1(*(const bf16_t*)(xT + swz144(pp, (16 * tt0 + fr) * 2))); xs1[i] = bf1(*(const bf16_t*)(xT + swz144(pp, (16 * tt0 + 16 + fr) * 2))); }
              f32x4 yi0 = (f32x4){0.f, 0.f, 0.f, 0.f}, yi1 = yi0, ys0 = yi0, ys1 = yi0;
#pragma unroll
              for (int ks = 0; ks < 2; ++ks) { yi0 = MFMA16(ax[ks], m0[ks], yi0); yi1 = MFMA16(ax[ks], m1[ks], yi1); }
#pragma unroll
              for (int ks = 0; ks < 4; ++ks) { ys0 = MFMA16(as_[ks], c0[ks], ys0); ys1 = MFMA16(as_[ks], c1[ks], ys1); }
              u32x2 w0, w1;
              w0.x = cvt_pk_bf16(yi0[0] + ea0 * ys0[0] + dsk * xs0[0], yi0[1] + ea0 * ys0[1] + dsk * xs0[1]); w0.y = cvt_pk_bf16(yi0[2] + ea0 * ys0[2] + dsk * xs0[2], yi0[3] + ea0 * ys0[3] + dsk * xs0[3]);
              w1.x = cvt_pk_bf16(yi1[0] + ea1 * ys1[0] + dsk * xs1[0], yi1[1] + ea1 * ys1[1] + dsk * xs1[1]); w1.y = cvt_pk_bf16(yi1[2] + ea1 * ys1[2] + dsk * xs1[2], yi1[3] + ea1 * ys1[3] + dsk * xs1[3]);
              if (!dry) { *(u32x2*)(P + (size_t)(row0 + 16 * tt0 + fr) * 5120 + 2048 + h * 64 + 16 * pt + 4 * fq) = w0; *(u32x2*)(P + (size_t)(row0 + 16 * tt0 + 16 + fr) * 5120 + 2048 + h * 64 + 16 * pt + 4 * fq) = w1; } }
          }
          { const int c = c0 + 1;
            const int row0 = b * SEQL + c * 64;
            LBAR();
            const float acs_end = pacs_endB;
            {
#pragma unroll
                for (int j = 0; j < 4; ++j) { const unsigned w = pxB[j]; const float x0 = bflo(w), x1 = bfhi(w);
                    *(bf16_t*)(xT + swz144(partx * 8 + 2 * j, sx * 2)) = (bf16_t)(w & 0xffffu); *(bf16_t*)(xT + swz144(partx * 8 + 2 * j + 1, sx * 2)) = (bf16_t)(w >> 16);
                    const unsigned d = cvt_pk_bf16(x0 * pdtB, x1 * pdtB);
                    *(bf16_t*)(xdtT + swz144(partx * 8 + 2 * j, sx * 2)) = (bf16_t)(d & 0xffffu); *(bf16_t*)(xdtT + swz144(partx * 8 + 2 * j + 1, sx * 2)) = (bf16_t)(d >> 16); }
#pragma unroll
                for (int i = 0; i < 2; ++i) { const int e = tid + 512 * i; const int sb = e >> 4, pt = e & 15;
                    *(u32x4*)(Bm + sb * 272 + pt * 16) = pbB[i]; *(u32x4*)(Cm + sb * 272 + pt * 16) = pcB[i];
                    const float dec = __expf(acs_end - pacsbB[i]);
#pragma unroll
                    for (int j = 0; j < 4; ++j) { const unsigned w = pbB[i][j]; const unsigned d = cvt_pk_bf16(bflo(w) * dec, bfhi(w) * dec);
                        *(bf16_t*)(BdT + swz144(pt * 8 + 2 * j, sb * 2)) = (bf16_t)(d & 0xffffu); *(bf16_t*)(BdT + swz144(pt * 8 + 2 * j + 1, sb * 2)) = (bf16_t)(d >> 16); } }
                if (tid < 64) acs_s[tid] = pacs_tB;
            }
            if (c + 2 < 64) SSD_LOAD(B, c + 2);
            LBAR();
            bf16x8 c0[4], c1[4];
            { const int stl = wave >> 1; const int tt0 = (wave & 1) * 2;
              bf16x8 a[4];
#pragma unroll
              for (int ks = 0; ks < 4; ++ks) { a[ks] = ldsfrag(Bm + (16 * stl + fr) * 272 + ks * 64 + fq * 16); c0[ks] = ldsfrag(Cm + (16 * tt0 + fr) * 272 + ks * 64 + fq * 16); c1[ks] = ldsfrag(Cm + (16 * (tt0 + 1) + fr) * 272 + ks * 64 + fq * 16); }
              const f32x4 as4 = *(const f32x4*)(acs_s + 16 * stl + 4 * fq); const float at0 = acs_s[16 * tt0 + fr], at1 = acs_s[16 * tt0 + 16 + fr];
              f32x4 d0 = (f32x4){0.f, 0.f, 0.f, 0.f}, d1 = d0;
#pragma unroll
              for (int ks = 0; ks < 4; ++ks) { d0 = MFMA16(a[ks], c0[ks], d0); d1 = MFMA16(a[ks], c1[ks], d1); }
#pragma unroll
              for (int tj = 0; tj < 2; ++tj) { const int t = 16 * (tt0 + tj) + fr; const float at = tj ? at1 : at0; const f32x4 d = tj ? d1 : d0; float mv[4];
#pragma unroll
                  for (int i = 0; i < 4; ++i) { const int sidx = 16 * stl + 4 * fq + i; const float e = __expf(fminf(at - as4[i], 0.f)); mv[i] = (sidx <= t) ? d[i] * e : 0.f; }
                  u32x2 w; w.x = cvt_pk_bf16(mv[0], mv[1]); w.y = cvt_pk_bf16(mv[2], mv[3]);
                  *(u32x2*)(Mt + t * 144 + (16 * stl + 4 * fq) * 2) = w; } }
            { const float ee = __expf(acs_end);
              const bf16x8 a0 = ldsfrag(BdT + swz144(16 * wave + fr, fq * 16)), a1 = ldsfrag(BdT + swz144(16 * wave + fr, 64 + fq * 16));
              bf16x8 xb0[4], xb1[4];
#pragma unroll
              for (int pt = 0; pt < 4; ++pt) { xb0[pt] = ldsfrag(xdtT + swz144(16 * pt + fr, fq * 16)); xb1[pt] = ldsfrag(xdtT + swz144(16 * pt + fr, 64 + fq * 16)); }
#pragma unroll
              for (int pt = 0; pt < 4; ++pt) st[pt] = st[pt] * ee;
#pragma unroll
              for (int pt = 0; pt < 4; ++pt) st[pt] = MFMA16(a0, xb0[pt], st[pt]);
#pragma unroll
              for (int pt = 0; pt < 4; ++pt) st[pt] = MFMA16(a1, xb1[pt], st[pt]);
#pragma unroll
              for (int pt = 0; pt < 4; ++pt) { u32x2 w; w.x = cvt_pk_bf16(st[pt][0], st[pt][1]); w.y = cvt_pk_bf16(st[pt][2], st[pt][3]);
                  *(u32x2*)(stB + ((c + 1) & 1) * 17408 + (16 * pt + fr) * 272 + (16 * wave + 4 * fq) * 2) = w; } }
            LBAR();
            { const int pt = wave >> 1; const int tt0 = (wave & 1) * 2;
              bf16x8 ax[2], as_[4], m0[2], m1[2];
#pragma unroll
              for (int ks = 0; ks < 2; ++ks) { ax[ks] = ldsfrag(xdtT + swz144(16 * pt + fr, ks * 64 + fq * 16)); m0[ks] = ldsfrag(Mt + (16 * tt0 + fr) * 144 + ks * 64 + fq * 16); m1[ks] = ldsfrag(Mt + (16 * tt0 + 16 + fr) * 144 + ks * 64 + fq * 16); }
#pragma unroll
              for (int ks = 0; ks < 4; ++ks) as_[ks] = ldsfrag(stB + (c & 1) * 17408 + (16 * pt + fr) * 272 + ks * 64 + fq * 16);
              const float ea0 = __expf(acs_s[16 * tt0 + fr]), ea1 = __expf(acs_s[16 * tt0 + 16 + fr]);
              float xs0[4], xs1[4];
#pragma unroll
              for (int i = 0; i < 4; ++i) { const int pp = 16 * pt + 4 * fq + i; xs0[i] = bf1(*(const bf16_t*)(xT + swz144(pp, (16 * tt0 + fr) * 2))); xs1[i] = bf1(*(const bf16_t*)(xT + swz144(pp, (16 * tt0 + 16 + fr) * 2))); }
              f32x4 yi0 = (f32x4){0.f, 0.f, 0.f, 0.f}, yi1 = yi0, ys0 = yi0, ys1 = yi0;
#pragma unroll
              for (int ks = 0; ks < 2; ++ks) { yi0 = MFMA16(ax[ks], m0[ks], yi0); yi1 = MFMA16(ax[ks], m1[ks], yi1); }
#pragma unroll
              for (int ks = 0; ks < 4; ++ks) { ys0 = MFMA16(as_[ks], c0[ks], ys0); ys1 = MFMA16(as_[ks], c1[ks], ys1); }
              u32x2 w0, w1;
              w0.x = cvt_pk_bf16(yi0[0] + ea0 * ys0[0] + dsk * xs0[0], yi0[1] + ea0 * ys0[1] + dsk * xs0[1]); w0.y = cvt_pk_bf16(yi0[2] + ea0 * ys0[2] + dsk * xs0[2], yi0[3] + ea0 * ys0[3] + dsk * xs0[3]);
              w1.x = cvt_pk_bf16(yi1[0] + ea1 * ys1[0] + dsk * xs1[0], yi1[1] + ea1 * ys1[1] + dsk * xs1[1]); w1.y = cvt_pk_bf16(yi1[2] + ea1 * ys1[2] + dsk * xs1[2], yi1[3] + ea1 * ys1[3] + dsk * xs1[3]);
              if (!dry) { *(u32x2*)(P + (size_t)(row0 + 16 * tt0 + fr) * 5120 + 2048 + h * 64 + 16 * pt + 4 * fq) = w0; *(u32x2*)(P + (size_t)(row0 + 16 * tt0 + 16 + fr) * 5120 + 2048 + h * 64 + 16 * pt + 4 * fq) = w1; } }
          }
        }
    }
}

__device__ __forceinline__ void ssd3_phase(const Params& p, int gw, int NGW, int lane) {
    bf16_t* P = (bf16_t*)(p.ws + WS_BIG);
    for (int m = gw; m < NTOK; m += NGW) {
        u32x4* yp = (u32x4*)(P + (size_t)m * 5120 + 2048 + 32 * lane); const u32x4* zp = (const u32x4*)(P + (size_t)m * 5120 + 32 * lane);
        float v[32]; float ss = 0.f;
#pragma unroll
        for (int q = 0; q < 4; ++q) { const u32x4 y = yp[q], z = __builtin_nontemporal_load(zp + q);
#pragma unroll
            for (int i = 0; i < 4; ++i) { const float a = bflo(y[i]) * fast_silu(bflo(z[i])), c = bfhi(y[i]) * fast_silu(bfhi(z[i])); v[8 * q + 2 * i] = a; v[8 * q + 2 * i + 1] = c; ss += a * a + c * c; } }
        ss += __shfl_xor(ss, 1); ss += __shfl_xor(ss, 2); ss += __shfl_xor(ss, 4); ss += __shfl_xor(ss, 8);
        const float rstd = rsqrtf(ss * (1.0f / 512.0f) + 1e-6f);
#pragma unroll
        for (int q = 0; q < 4; ++q) { u32x4 w;
#pragma unroll
            for (int i = 0; i < 4; ++i) w[i] = cvt_pk_bf16(v[8 * q + 2 * i] * rstd, v[8 * q + 2 * i + 1] * rstd);
            yp[q] = w; }
    }
}

__device__ __forceinline__ void sb_attn_phase(const Params& p, unsigned char* lds, int bid, int G, int tid, int wave, int lane) {
    unsigned char* ws = p.ws;
    const bf16_t* P = (const bf16_t*)(ws + WS_BIG); bf16_t* AO = (bf16_t*)(ws + WS_BIG + BIG_SB_AO);
    unsigned char* Ks = lds;
    unsigned char* VTs = lds + 9216;
    int* flags = (int*)(lds + 18432);
    const int fr = lane & 15, fq = lane >> 4;
    bf16x8 U[4][2], ones;
#pragma unroll
    for (int jj = 0; jj < 8; ++jj) ones[jj] = (short)0x3F80;
#pragma unroll
    for (int io = 0; io < 4; ++io)
#pragma unroll
        for (int ks = 0; ks < 2; ++ks)
#pragma unroll
            for (int jj = 0; jj < 8; ++jj) { const int kj = 32 * ks + (jj < 4 ? 4 * fq + jj : 16 + 4 * fq + (jj - 4)); U[io][ks][jj] = (kj > 16 * io + fr) ? (short)0x3F80 : (short)0; }
    const int ss_ = tid >> 3, part_ = tid & 7; u32x4 pkkA, pvvA, pkkB, pvvB;
#define SB_LOAD(S_, b_, h_, kt_) do { const size_t krow_ = (size_t)((b_) * SEQL + 64 * (kt_) + ss_) * 3072; pkk##S_ = *(const u32x4*)(P + krow_ + 1024 + (h_) * 64 + part_ * 8); pvv##S_ = *(const u32x4*)(P + krow_ + 2048 + (h_) * 64 + part_ * 8); } while (0)
    if (bid < 4096) { const int qbn = 31 - (bid >> 7), bhn = bid & 127; SB_LOAD(A, bhn >> 4, bhn & 15, qbn * 2 + 1); SB_LOAD(B, bhn >> 4, bhn & 15, qbn * 2); }
    for (int u = bid; u < 4096; u += G) {
        const int qb = 31 - (u >> 7), bh = u & 127, b = bh >> 4, h = bh & 15;
        const int q0 = qb * 128; const int tq = q0 + 16 * wave + fr;
        const size_t qrow = (size_t)(b * SEQL + tq);
        const bf16x8 bq0 = *(const bf16x8*)(P + qrow * 3072 + h * 64 + fq * 8), bq1 = *(const bf16x8*)(P + qrow * 3072 + h * 64 + 32 + fq * 8);
        f32x4 O[4];
#pragma unroll
        for (int i = 0; i < 4; ++i) O[i] = (f32x4){0.f, 0.f, 0.f, 0.f};
        float carry = 0.f; bool wdone_prev = false;
        const int kt_hi = q0 / 64 + 1;
        for (int kt0 = kt_hi; kt0 >= 0; kt0 -= 2) {
          { const int kt = kt0;
            LBAR();
            if (kt != kt_hi) { int fs = 0;
#pragma unroll
                for (int i = 0; i < 8; ++i) fs += flags[i];
                if (fs == 8) break; }
            { *(u32x4*)(Ks + ss_ * 144 + part_ * 16) = pkkA;
#pragma unroll
              for (int i = 0; i < 4; ++i) { *(bf16_t*)(VTs + swz144(part_ * 8 + 2 * i, ss_ * 2)) = (bf16_t)(pvvA[i] & 0xffffu); *(bf16_t*)(VTs + swz144(part_ * 8 + 2 * i + 1, ss_ * 2)) = (bf16_t)(pvvA[i] >> 16); } }
            if (kt > 1) SB_LOAD(A, b, h, kt - 2);
            LBAR();
            const bool wskip = wdone_prev || (64 * kt >= q0 + 16 * wave + 15);
            if (!wskip) {
            const bool need_mask = (64 * kt + 63 >= q0 + 16 * wave);
            float nl[4][4], lz[4][4];
            bf16x8 kf0[4], kf1[4];
#pragma unroll
            for (int io = 0; io < 4; ++io) { kf0[io] = ldsfrag(Ks + (16 * io + fr) * 144 + fq * 16); kf1[io] = ldsfrag(Ks + (16 * io + fr) * 144 + 64 + fq * 16); }
            f32x4 zt[4];
#pragma unroll
            for (int io = 0; io < 4; ++io) zt[io] = MFMA16(kf0[io], bq0, ((f32x4){0.f, 0.f, 0.f, 0.f}));
#pragma unroll
            for (int io = 0; io < 4; ++io) zt[io] = MFMA16(kf1[io], bq1, zt[io]);
#pragma unroll
            for (int io = 0; io < 4; ++io) { const f32x4 z = zt[io];
#pragma unroll
                for (int i = 0; i < 4; ++i) { const float zz = z[i];
                    const float sp = fmaxf(zz, 0.f) + __builtin_amdgcn_logf(1.f + __builtin_amdgcn_exp2f(-fabsf(zz)));
                    nl[io][i] = sp; lz[io][i] = zz - sp; } }
            if (need_mask) {
#pragma unroll
                for (int io = 0; io < 4; ++io)
#pragma unroll
                    for (int i = 0; i < 4; ++i) { const int key = 64 * kt + 16 * io + 4 * fq + i; if (key >= tq) { nl[io][i] = 0.f; lz[io][i] = -1e30f; } } }
            bf16x8 bh_[2];
#pragma unroll
            for (int ks = 0; ks < 2; ++ks) { u32x4 w; w.x = cvt_pk_bf16(nl[2 * ks][0], nl[2 * ks][1]); w.y = cvt_pk_bf16(nl[2 * ks][2], nl[2 * ks][3]); w.z = cvt_pk_bf16(nl[2 * ks + 1][0], nl[2 * ks + 1][1]); w.w = cvt_pk_bf16(nl[2 * ks + 1][2], nl[2 * ks + 1][3]); bh_[ks] = __builtin_bit_cast(bf16x8, w); }
            f32x4 tot = (f32x4){0.f, 0.f, 0.f, 0.f};
#pragma unroll
            for (int ks = 0; ks < 2; ++ks) tot = MFMA16(ones, bh_[ks], tot);
            float att[4][4];
#pragma unroll
            for (int io = 0; io < 4; ++io) { f32x4 sv = (f32x4){0.f, 0.f, 0.f, 0.f};
#pragma unroll
                for (int ks = 0; ks < 2; ++ks) sv = MFMA16(U[io][ks], bh_[ks], sv);
#pragma unroll
                for (int i = 0; i < 4; ++i) att[io][i] = __builtin_amdgcn_exp2f((lz[io][i] + carry) - sv[i]); }
            carry -= tot[0];
            bf16x8 pa[2];
#pragma unroll
            for (int ks = 0; ks < 2; ++ks) { u32x4 w; w.x = cvt_pk_bf16(att[2 * ks][0], att[2 * ks][1]); w.y = cvt_pk_bf16(att[2 * ks][2], att[2 * ks][3]); w.z = cvt_pk_bf16(att[2 * ks + 1][0], att[2 * ks + 1][1]); w.w = cvt_pk_bf16(att[2 * ks + 1][2], att[2 * ks + 1][3]); pa[ks] = __builtin_bit_cast(bf16x8, w); }
#pragma unroll
            for (int ks = 0; ks < 2; ++ks) { bf16x8 vf[4];
#pragma unroll
                for (int dt = 0; dt < 4; ++dt) { const u32x2 lo = *(const u32x2*)(VTs + swz144(16 * dt + fr, (32 * ks + 4 * fq) * 2)), hi = *(const u32x2*)(VTs + swz144(16 * dt + fr, (32 * ks + 16 + 4 * fq) * 2)); const u32x4 w = (u32x4){lo.x, lo.y, hi.x, hi.y}; vf[dt] = __builtin_bit_cast(bf16x8, w); }
#pragma unroll
                for (int dt = 0; dt < 4; ++dt) O[dt] = MFMA16(vf[dt], pa[ks], O[dt]); }
            }
            const bool wdone = (__builtin_amdgcn_ballot_w64(carry >= -152.0f) == 0ull);
            wdone_prev = wdone;
            if (lane == 0) flags[wave] = wdone ? 1 : 0;
          }
          if (kt0 == 0) break;
          { const int kt = kt0 - 1;
            LBAR();
            if (kt != kt_hi) { int fs = 0;
#pragma unroll
                for (int i = 0; i < 8; ++i) fs += flags[i];
                if (fs == 8) break; }
            { *(u32x4*)(Ks + ss_ * 144 + part_ * 16) = pkkB;
#pragma unroll
              for (int i = 0; i < 4; ++i) { *(bf16_t*)(VTs + swz144(part_ * 8 + 2 * i, ss_ * 2)) = (bf16_t)(pvvB[i] & 0xffffu); *(bf16_t*)(VTs + swz144(part_ * 8 + 2 * i + 1, ss_ * 2)) = (bf16_t)(pvvB[i] >> 16); } }
            if (kt > 1) SB_LOAD(B, b, h, kt - 2);
            LBAR();
            const bool wskip = wdone_prev || (64 * kt >= q0 + 16 * wave + 15);
            if (!wskip) {
            const bool need_mask = (64 * kt + 63 >= q0 + 16 * wave);
            float nl[4][4], lz[4][4];
            bf16x8 kf0[4], kf1[4];
#pragma unroll
            for (int io = 0; io < 4; ++io) { kf0[io] = ldsfrag(Ks + (16 * io + fr) * 144 + fq * 16); kf1[io] = ldsfrag(Ks + (16 * io + fr) * 144 + 64 + fq * 16); }
            f32x4 zt[4];
#pragma unroll
            for (int io = 0; io < 4; ++io) zt[io] = MFMA16(kf0[io], bq0, ((f32x4){0.f, 0.f, 0.f, 0.f}));
#pragma unroll
            for (int io = 0; io < 4; ++io) zt[io] = MFMA16(kf1[io], bq1, zt[io]);
#pragma unroll
            for (int io = 0; io < 4; ++io) { const f32x4 z = zt[io];
#pragma unroll
                for (int i = 0; i < 4; ++i) { const float zz = z[i];
                    const float sp = fmaxf(zz, 0.f) + __builtin_amdgcn_logf(1.f + __builtin_amdgcn_exp2f(-fabsf(zz)));
                    nl[io][i] = sp; lz[io][i] = zz - sp; } }
            if (need_mask) {
#pragma unroll
                for (int io = 0; io < 4; ++io)
#pragma unroll
                    for (int i = 0; i < 4; ++i) { const int key = 64 * kt + 16 * io + 4 * fq + i; if (key >= tq) { nl[io][i] = 0.f; lz[io][i] = -1e30f; } } }
            bf16x8 bh_[2];
#pragma unroll
            for (int ks = 0; ks < 2; ++ks) { u32x4 w; w.x = cvt_pk_bf16(nl[2 * ks][0], nl[2 * ks][1]); w.y = cvt_pk_bf16(nl[2 * ks][2], nl[2 * ks][3]); w.z = cvt_pk_bf16(nl[2 * ks + 1][0], nl[2 * ks + 1][1]); w.w = cvt_pk_bf16(nl[2 * ks + 1][2], nl[2 * ks + 1][3]); bh_[ks] = __builtin_bit_cast(bf16x8, w); }
            f32x4 tot = (f32x4){0.f, 0.f, 0.f, 0.f};
#pragma unroll
            for (int ks = 0; ks < 2; ++ks) tot = MFMA16(ones, bh_[ks], tot);
            float att[4][4];
#pragma unroll
            for (int io = 0; io < 4; ++io) { f32x4 sv = (f32x4){0.f, 0.f, 0.f, 0.f};
#pragma unroll
                for (int ks = 0; ks < 2; ++ks) sv = MFMA16(U[io][ks], bh_[ks], sv);
#pragma unroll
                for (int i = 0; i < 4; ++i) att[io][i] = __builtin_amdgcn_exp2f((lz[io][i] + carry) - sv[i]); }
            carry -= tot[0];
            bf16x8 pa[2];
#pragma unroll
            for (int ks = 0; ks < 2; ++ks) { u32x4 w; w.x = cvt_pk_bf16(att[2 * ks][0], att[2 * ks][1]); w.y = cvt_pk_bf16(att[2 * ks][2], att[2 * ks][3]); w.z = cvt_pk_bf16(att[2 * ks + 1][0], att[2 * ks + 1][1]); w.w = cvt_pk_bf16(att[2 * ks + 1][2], att[2 * ks + 1][3]); pa[ks] = __builtin_bit_cast(bf16x8, w); }
#pragma unroll
            for (int ks = 0; ks < 2; ++ks) { bf16x8 vf[4];
#pragma unroll
                for (int dt = 0; dt < 4; ++dt) { const u32x2 lo = *(const u32x2*)(VTs + swz144(16 * dt + fr, (32 * ks + 4 * fq) * 2)), hi = *(const u32x2*)(VTs + swz144(16 * dt + fr, (32 * ks + 16 + 4 * fq) * 2)); const u32x4 w = (u32x4){lo.x, lo.y, hi.x, hi.y}; vf[dt] = __builtin_bit_cast(bf16x8, w); }
#pragma unroll
                for (int dt = 0; dt < 4; ++dt) O[dt] = MFMA16(vf[dt], pa[ks], O[dt]); }
            }
            const bool wdone = (__builtin_amdgcn_ballot_w64(carry >= -152.0f) == 0ull);
            wdone_prev = wdone;
            if (lane == 0) flags[wave] = wdone ? 1 : 0;
          }
        }
        { const int un = u + G; if (un < 4096) { const int qbn = 31 - (un >> 7), bhn = un & 127; SB_LOAD(A, bhn >> 4, bhn & 15, qbn * 2 + 1); SB_LOAD(B, bhn >> 4, bhn & 15, qbn * 2); } }
#pragma unroll
        for (int dt = 0; dt < 4; ++dt) { u32x2 w; w.x = cvt_pk_bf16(O[dt][0], O[dt][1]); w.y = cvt_pk_bf16(O[dt][2], O[dt][3]);
            *(u32x2*)(AO + qrow * DM + h * 64 + 16 * dt + 4 * fq) = w; }
    }
}

__device__ __forceinline__ void ffn_fix_phase(const Params& p, int layer, int bid, int G, int tid) {
    const float* side = (const float*)(p.ws + WS_BIG + 176 * MiB); bf16_t* act = (bf16_t*)(p.ws + WS_BIG);
    const float* cw = p.in[I_FFN_CW] + (size_t)layer * 3 * 5632; const float* cb = p.in[I_FFN_CB] + (size_t)layer * 5632;
    for (int idx = bid * 512 + tid; idx < 128 * 2 * 704; idx += G * 512) {
        const int q = idx % 704, r = idx / 704, tau = r & 1, pm = r >> 1;
        if ((pm & 15) == 0) continue;
        const int c = q * 4, col = (c >> 7) * 256 + (c & 127);
        const float* s0 = side + ((size_t)pm * 4 + tau) * 5632 + col;
        const float* s1 = tau ? side + ((size_t)pm * 4) * 5632 + col : side + ((size_t)(pm - 1) * 4 + 3) * 5632 + col;
        const float* s2 = tau ? side + ((size_t)(pm - 1) * 4 + 3) * 5632 + col : side + ((size_t)(pm - 1) * 4 + 2) * 5632 + col;
        const f32x4 g = *(const f32x4*)(cb + c) + *(const f32x4*)(cw + 2 * 5632 + c) * *(const f32x4*)s0 + *(const f32x4*)(cw + 5632 + c) * *(const f32x4*)s1 + *(const f32x4*)(cw + c) * *(const f32x4*)s2;
        const f32x4 v = *(const f32x4*)(cb + FFD + c) + *(const f32x4*)(cw + 2 * 5632 + FFD + c) * *(const f32x4*)(s0 + 128) + *(const f32x4*)(cw + 5632 + FFD + c) * *(const f32x4*)(s1 + 128) + *(const f32x4*)(cw + FFD + c) * *(const f32x4*)(s2 + 128);
        u32x2 w; w.x = cvt_pk_bf16(fast_silu(g[0]) * v[0], fast_silu(g[1]) * v[1]); w.y = cvt_pk_bf16(fast_silu(g[2]) * v[2], fast_silu(g[3]) * v[3]);
        *(u32x2*)(act + ((size_t)(c >> 6) * NTOK + (pm * 256 + tau)) * 64 + (c & 63)) = w;
    }
}

__device__ __forceinline__ void final_phase(const Params& p, int gw, int NGW, int lane) {
    const float* rssp = (const float*)(p.ws + WS_RSSP); const bf16_t* XB = (const bf16_t*)(p.ws + WS_XB);
    f32x4 wv[4];
#pragma unroll
    for (int j = 0; j < 4; ++j) wv[j] = ((const f32x4*)p.in[I_FINNW] + lane)[64 * j];
    for (int m = gw; m < NTOK; m += NGW) { const float rs = row_rstd(rssp, m); f32x4* xr = (f32x4*)(p.out + (size_t)m * DM) + lane; const u32x2* xi = (const u32x2*)(XB + (size_t)m * DM) + lane;
#pragma unroll
        for (int j = 0; j < 4; ++j) { const u32x2 w = __builtin_nontemporal_load(xi + 64 * j); f32x4 v = (f32x4){bflo(w.x), bfhi(w.x), bflo(w.y), bfhi(w.y)}; __builtin_nontemporal_store(v * rs * wv[j], xr + 64 * j); } }
}

#define XB_TMO      128
#define XB_XCNT(j)  (256  + 64 * (j))
#define XB_XSUB(j)  (1280 + 64 * (j))
#define XB_XGEN(j)  (2304 + 64 * (j))
#define XB_TOP      3328
#define XB_TOPGEN   3392
#define XCD_BAR_WORDS 3456
#define XB_SPIN_CAP (1u << 22)
__device__ __forceinline__ unsigned xb_ld(unsigned* p)              { return __hip_atomic_load(p, __ATOMIC_RELAXED, __HIP_MEMORY_SCOPE_AGENT); }
__device__ __forceinline__ unsigned xb_add(unsigned* p, unsigned v) { return __hip_atomic_fetch_add(p, v, __ATOMIC_RELAXED, __HIP_MEMORY_SCOPE_AGENT); }
__device__ __forceinline__ unsigned xb_xcc_id() { return (unsigned)__builtin_amdgcn_s_getreg((3 << 11) | 20) & 0xFu; }
#define XB_SPIN(cond, bar) do { unsigned _sp = 0; while (cond) { __builtin_amdgcn_s_sleep(1); \
    if ((++_sp & 255u) == 0u) { if (xb_ld(&(bar)[XB_TMO])) break; if (_sp > XB_SPIN_CAP) { atomicAdd(&(bar)[XB_TMO], 1u); break; } } } } while (0)
struct XcdBarrier { unsigned* bar; unsigned x; volatile LAS unsigned* st; };
__device__ __forceinline__ XcdBarrier xcd_barrier_post(unsigned* bar, volatile LAS unsigned* st) {
    XcdBarrier b; b.bar = bar; b.x = xb_xcc_id(); b.st = st;
    if (threadIdx.x == 0) (void)xb_add(&bar[XB_XCNT(b.x)], 1u);
    return b;
}
__device__ __forceinline__ void xcd_barrier_complete(unsigned* bar, unsigned x, unsigned& nloc, unsigned& nx) {
    const unsigned G = gridDim.x * gridDim.y * gridDim.z;
    unsigned sum, cnt, mine, sp = 0u;
    for (;;) {
        sum = 0u; cnt = 0u; mine = 0u;
#pragma unroll 1
        for (unsigned j = 0; j < 16; ++j) { const unsigned c = xb_ld(&bar[XB_XCNT(j)]); sum += c; cnt += (c > 0u) ? 1u : 0u; mine = (j == x) ? c : mine; }
        if (sum == G) break;
        __builtin_amdgcn_s_sleep(1);
        if ((++sp & 255u) == 0u) { if (xb_ld(&bar[XB_TMO])) break; if (sp > XB_SPIN_CAP) { atomicAdd(&bar[XB_TMO], 1u); break; } }
    }
    nloc = mine > 0u ? mine : 1u; nx = cnt > 0u ? cnt : 1u;
}
__device__ __forceinline__ void xcd_barrier(const XcdBarrier& b) {
    asm volatile("s_waitcnt vmcnt(0)" ::: "memory");
    __syncthreads();
    if (threadIdx.x == 0) {
        unsigned* bar = b.bar; asm volatile("" : "+s"(bar));
        __builtin_amdgcn_s_waitcnt(0);
        unsigned nloc = b.st[0], nx = b.st[1];
        if (nloc == 0u) { xcd_barrier_complete(bar, b.x, nloc, nx); b.st[0] = nloc; b.st[1] = nx; }
        const unsigned old = xb_add(&bar[XB_XSUB(b.x)], 1u);
        const unsigned gen = old / nloc;
        if (old + 1u == (gen + 1u) * nloc) {
            __builtin_amdgcn_fence(__ATOMIC_RELEASE, "agent");
            asm volatile("s_waitcnt vmcnt(0)" ::: "memory");
            const unsigned og = xb_add(&bar[XB_TOP], 1u);
            const unsigned tg = og / nx;
            if (og + 1u == (tg + 1u) * nx) xb_add(&bar[XB_TOPGEN], 1u);
            else XB_SPIN(xb_ld(&bar[XB_TOPGEN]) == tg, bar);
            __builtin_amdgcn_fence(__ATOMIC_ACQUIRE, "agent");
            xb_add(&bar[XB_XGEN(b.x)], 1u);
            asm volatile("s_waitcnt vmcnt(0)" ::: "memory");
        } else {
            XB_SPIN(xb_ld(&bar[XB_XGEN(b.x)]) == gen, bar);
            __builtin_amdgcn_fence(__ATOMIC_ACQUIRE, "agent");
            asm volatile("s_waitcnt vmcnt(0)" ::: "memory");
        }
    }
    __syncthreads();
}
constexpr size_t WS_BARW = 102 * MiB;
#ifdef DBG
__device__ __noinline__ void dbg_scan(const void* ptr, size_t nbytes, int is_f32, unsigned code, unsigned* dbg, int gtid, int gthreads) {
    const u32x4* q = (const u32x4*)ptr; const size_t n = nbytes / 16; bool bad = false;
    for (size_t i = gtid; i < n; i += gthreads) { const u32x4 v = q[i];
#pragma unroll
        for (int e = 0; e < 4; ++e) { if (is_f32) bad |= ((v[e] & 0x7f800000u) == 0x7f800000u); else bad |= ((v[e] & 0x7f80u) == 0x7f80u) | ((v[e] & 0x7f800000u) == 0x7f800000u); } }
    if (bad) atomicMin(dbg, code);
}
#define SCAN(ptr, nbytes, isf, code) do { dbg_scan((ptr), (nbytes), (isf), (code), dbgw, bid * 512 + (int)threadIdx.x, G * 512); grid.sync(); } while (0)
#else
#define SCAN(ptr, nbytes, isf, code) do { } while (0)
#endif
constexpr int LDS_BYTES = 147456;
__global__ void __launch_bounds__(512, 2) mega_fwd(Params p) {
    extern __shared__ __attribute__((aligned(16))) unsigned char lds[];
    cg::grid_group grid = cg::this_grid();
    const int G = gridDim.x, bid = blockIdx.x; const int NGW = G * 8;
    int tid, lane, wave, gw;
#define FRESH() do { tid = threadIdx.x; asm volatile("" : "+v"(tid)); lane = tid & 63; wave = __builtin_amdgcn_readfirstlane(tid >> 6); gw = bid * 8 + wave; } while (0)
    FRESH();
    unsigned char* ws = p.ws;
    float* RSSP0 = (float*)(ws + WS_RSSP); float* RSSP1 = RSSP0 + RSSP_STRIDE;
    bf16_t* XB = (bf16_t*)(ws + WS_XB); bf16_t* BIG = (bf16_t*)(ws + WS_BIG);
#ifdef DBG
    unsigned* dbgw = (unsigned*)(ws + 102 * MiB + 65536);
#endif

#ifndef PH
#define PH 0xFFFF
#endif
#define ON(k) ((PH >> (k)) & 1)
#ifndef REP
#define REP 0
#endif
#define NREP(k) (((REP) >> (k)) & 1)
#define RUN(k, call) do { if (ON(k)) { for (int rep_ = NREP(k); rep_ >= 0; --rep_) { const int dry = rep_; (void)dry; FRESH(); call; if (rep_) grid.sync(); } } } while (0)
    { volatile LAS unsigned* bst_ = (volatile LAS unsigned*)(LAS unsigned char*)(lds + LDS_BYTES - 16); if (threadIdx.x == 0) { bst_[0] = 0u; bst_[1] = 0u; } }
    __syncthreads();
    const XcdBarrier xbar = xcd_barrier_post((unsigned*)(ws + WS_BARW), (volatile LAS unsigned*)(LAS unsigned char*)(lds + LDS_BYTES - 16));
    RUN(0, prep_phase(p, lds, gw, NGW, wave, lane));
#ifdef XSYNC
    for (int i_ = 0; i_ < XSYNC; ++i_) grid.sync();
#endif
    if (p.out == nullptr) grid.sync();
    xcd_barrier(xbar);
    SCAN(XB, (size_t)NTOK * DM * 2, 0, 1); SCAN(RSSP0, (size_t)NTOK * 16, 1, 2); SCAN(ws + WS_W, W_END - WS_W, 0, 3);
    for (int layer = 0; layer < 4; ++layer) {
        if (layer == 1) { RUN(1, pool_dlt_phase(p, lds, bid, G, tid)); }
        else if (layer == 2) {
            pg8::Sched S; S.init(128, 21, G, bid, 0, 256L * 2048, 0, 256L * 2048);
            pg8::EpiSsdIn E{BIG, RSSP0, (float*)(ws + WS_BIG + BIG_SSD_DT), p.in[I_SSD_CW], p.in[I_SSD_CB], (float*)((unsigned char*)p.out + XBR_HALO)};
            FRESH(); pg8::gemm_phase<pg8::EpiSsdIn>(lds, XB, (const bf16_t*)(ws + W_SSD_IN), 1024, 1024, S, E, tid);
        }
        else {
            pg8::Sched S; pg8::EpiProj E; const bf16_t* Bt;
            if (layer == 0) { Bt = (const bf16_t*)(ws + W_GLA_IN); S.init(128, 13, G, bid, 0, 256L * 2048, 0, 256L * 2048); E = pg8::EpiProj{BIG, 3072, RSSP0, 12, (float*)(ws + WS_BIG + BIG_GLA_GLR), 16}; }
            else if (layer == 2) { Bt = (const bf16_t*)(ws + W_SSD_IN); S.init(128, 21, G, bid, 0, 256L * 2048, 0, 256L * 2048); E = pg8::EpiProj{BIG, 5120, RSSP0, 20, (float*)(ws + WS_BIG + BIG_SSD_DT), 32}; }
            else { Bt = (const bf16_t*)(ws + W_SB_QKV); S.init(128, 12, G, bid, 0, 256L * 2048, 0, 256L * 2048); E = pg8::EpiProj{BIG, 3072, RSSP0, -1, nullptr, 0}; }
            RUN(2, pg8::gemm_phase<pg8::EpiProj>(lds, XB, Bt, 1024, 1024, S, E, tid));
        }
        xcd_barrier(xbar);
        if (layer == 0) { SCAN(BIG, (size_t)NTOK * 3072 * 2, 0, 10); SCAN(ws + WS_BIG + BIG_GLA_GLR, (size_t)NTOK * 64, 1, 11); }
        else if (layer == 1) { SCAN(BIG, (size_t)NTOK * 1024 * 2, 0, 20); }
        else if (layer == 2) { SCAN(BIG, (size_t)NTOK * 5120 * 2, 0, 30); SCAN(ws + WS_BIG + BIG_SSD_DT, (size_t)NTOK * 128, 1, 31); }
        else { SCAN(BIG, (size_t)NTOK * 3072 * 2, 0, 40); }
        if (layer == 0) { RUN(3, gla1_phase(p, lds, bid, G, tid)); xcd_barrier(xbar); SCAN(ws + WS_BIG + BIG_GLA_KDT, 32 * MiB, 0, 12); SCAN(ws + WS_XB, 64 * MiB, 0, 13); for (int gp_ = 1; gp_ <= 2; ++gp_) { FRESH(); gla_scan_phase(p, lds, bid, G, tid, wave, lane, gp_); if (gp_ == 1) { xcd_barrier(xbar); FRESH(); gla_combine_phase(p, bid, G, tid); xcd_barrier(xbar); } } xcd_barrier(xbar); SCAN(ws + WS_BIG + BIG_GLA_OPRE, 64 * MiB, 0, 14); if (ON(5)) { FRESH(); gla3_phase(p, gw, NGW, lane); } xcd_barrier(xbar); SCAN(ws + WS_BIG + BIG_GLA_OPRE, 64 * MiB, 0, 15); }
        else if (layer == 2) { FRESH(); ssd_dt_fix_phase(p, lds, bid, G, tid); xcd_barrier(xbar); RUN(6, ssd_scan_phase(p, lds, bid, G, tid, wave, lane, dry)); xcd_barrier(xbar); SCAN(BIG, (size_t)NTOK * 5120 * 2, 0, 32); if (ON(7)) { FRESH(); ssd3_phase(p, gw, NGW, lane); } xcd_barrier(xbar); SCAN(BIG, (size_t)NTOK * 5120 * 2, 0, 33); }
        else if (layer == 3) { RUN(8, sb_attn_phase(p, lds, bid, G, tid, wave, lane)); xcd_barrier(xbar); SCAN(ws + WS_BIG + BIG_SB_AO, 64 * MiB, 0, 41); }
        {
            pg8::Sched S; pg8::EpiResid E{XB, RSSP1, nullptr, nullptr, 0}; const bf16_t* A; const bf16_t* Bt; int lda, K;
            if (layer == 0) { A = (const bf16_t*)(ws + WS_BIG + BIG_GLA_OPRE); Bt = (const bf16_t*)(ws + W_GLA_OUT); lda = 1024; K = 1024; S.init(128, 4, G, bid, 0, 256L * 2048, 0, 256L * 2048); }
            else if (layer == 1) { A = BIG; Bt = (const bf16_t*)(ws + W_POOL); lda = 1024; K = 256; S.init(128, 4, G, bid, 0, 256L * 2048, 512, 256L * 512); E.bias = p.in[I_POOL_B]; E.scale = p.in[I_POOL_SC]; }
            else if (layer == 2) { A = BIG + 2048; Bt = (const bf16_t*)(ws + W_SSD_OUT); lda = 5120; K = 2048; S.init(128, 4, G, bid, 0, 256L * 10240, 0, 256L * 4096); }
            else { A = (const bf16_t*)(ws + WS_BIG + BIG_SB_AO); Bt = (const bf16_t*)(ws + W_SB_OUT); lda = 1024; K = 1024; S.init(128, 4, G, bid, 0, 256L * 2048, 0, 256L * 2048); }
            RUN(9, (E.dry = dry, pg8::gemm_phase<pg8::EpiResid>(lds, A, Bt, lda, K, S, E, tid)));
        }
        xcd_barrier(xbar);
        SCAN(p.out, (size_t)NTOK * DM * 4, 1, 10 * (layer + 1) + 5); SCAN(RSSP1, (size_t)NTOK * 16, 1, 10 * (layer + 1) + 6);
        {
            pg8::Sched S; S.init(128, 22, G, bid, 0, 256L * 2048, 0, 256L * 2048);
            pg8::EpiFfnUp E{BIG, RSSP1, p.in[I_FFN_CW] + (size_t)layer * 3 * 5632, p.in[I_FFN_CB] + (size_t)layer * 5632, (float*)(ws + WS_BIG + 176 * MiB)};
            RUN(10, pg8::gemm_phase<pg8::EpiFfnUp>(lds, XB, (const bf16_t*)(ws + WS_W + layer * W_FFN_STRIDE), 1024, 1024, S, E, tid));
        }
        xcd_barrier(xbar);
        FRESH(); ffn_fix_phase(p, layer, bid, G, tid);
        xcd_barrier(xbar);
        SCAN(BIG, (size_t)NTOK * FFD * 2, 0, 10 * (layer + 1) + 7);
        {
            pg8::Sched S; S.init(128, 4, G, bid, 0, 256L * 128, 0, 256L * 5632);
            pg8::EpiResid E{XB, RSSP0, nullptr, nullptr, 0};
            RUN(11, (E.dry = dry, pg8::gemm_phase<pg8::EpiResid>(lds, BIG, (const bf16_t*)(ws + WS_W + layer * W_FFN_STRIDE + W_FFN_DOWN_OFF), 64, FFD, S, E, tid, (size_t)NTOK * 128)));
        }
        xcd_barrier(xbar);
        SCAN(p.out, (size_t)NTOK * DM * 4, 1, 10 * (layer + 1) + 8);
    }
    if (ON(12)) { FRESH(); final_phase(p, gw, NGW, lane); }
#ifdef DBG
    xcd_barrier(xbar);
    if (bid == 0 && threadIdx.x == 0) { const unsigned dv = *dbgw; p.out[0] = dv > 1000u ? 0.f : 100.f * (float)dv; }
#endif
}

extern "C" void kernel_launch(void* const* d_in, const int* in_sizes, int n_in, void* d_out, int out_size, void* d_ws, size_t ws_size, hipStream_t stream) {
    static int grid = 0;
    if (grid == 0) {
        if (n_in != 26 || out_size != NTOK * DM || ws_size < WS_NEED) { fprintf(stderr, "kernel_launch: unexpected problem (n_in %d, out %d, ws %zu)\n", n_in, out_size, ws_size); grid = -1; return; }
        int dev = 0, cus = 0, per_cu = 0;
        hipGetDevice(&dev); hipDeviceGetAttribute(&cus, hipDeviceAttributeMultiprocessorCount, dev);
        hipFuncSetAttribute((const void*)mega_fwd, hipFuncAttributeMaxDynamicSharedMemorySize, LDS_BYTES);
        hipOccupancyMaxActiveBlocksPerMultiprocessor(&per_cu, (const void*)mega_fwd, 512, LDS_BYTES);
        if (per_cu < 1) per_cu = 1;
        grid = cus * 1;
        (void)hipGetLastError();
    }
    if (grid < 0) return;
    if (hipMemsetAsync((unsigned char*)d_ws + WS_BARW, 0, 16384, stream) != hipSuccess) { fprintf(stderr, "kernel_launch: memset failed\n"); return; }
    Params p{};
    for (int i = 0; i < 26; ++i) p.in[i] = (const float*)d_in[i];
    p.out = (float*)d_out; p.ws = (unsigned char*)d_ws;
#ifdef DBG
    hipMemsetAsync((unsigned char*)d_ws + 102 * MiB + 65536, 0x7f, 64, stream);
#endif
    void* args[] = {&p};
    hipError_t e = hipLaunchCooperativeKernel((const void*)mega_fwd, dim3(grid), dim3(512), args, LDS_BYTES, stream);
    if (e != hipSuccess) fprintf(stderr, "cooperative launch failed: %s (grid %d)\n", hipGetErrorString(e), grid);
}
```

```cpp
#include <hip/hip_runtime.h>
#include <hip/hip_cooperative_groups.h>
#include <cstdio>
#include <cstdint>
namespace cg = cooperative_groups;

#define LAS __attribute__((address_space(3)))
typedef unsigned short bf16_t;
typedef short bf16x8 __attribute__((ext_vector_type(8)));
typedef float f32x4 __attribute__((ext_vector_type(4)));
typedef unsigned u32x4 __attribute__((ext_vector_type(4)));
typedef unsigned u32x2 __attribute__((ext_vector_type(2)));

constexpr int NTOK = 32768, DM = 1024, SEQL = 4096;
constexpr int FFD = 2816;
constexpr size_t MiB = 1u << 20;
constexpr size_t WS_RSSP = 0;
constexpr size_t RSSP_STRIDE = (size_t)NTOK * 4;
constexpr size_t WS_W = 4 * MiB;
constexpr size_t W_FFN_STRIDE = 16 * MiB + MiB / 2;
constexpr size_t W_FFN_DOWN_OFF = 11 * MiB;
constexpr size_t W_GLA_IN = WS_W + 66 * MiB;
constexpr size_t W_GLA_OUT = W_GLA_IN + 6 * MiB + MiB / 2;
constexpr size_t W_POOL = W_GLA_OUT + 2 * MiB;
constexpr size_t W_SSD_IN = W_POOL + MiB / 2;
constexpr size_t W_SSD_OUT = W_SSD_IN + 10 * MiB + MiB / 2;
constexpr size_t W_SB_QKV = W_SSD_OUT + 4 * MiB;
constexpr size_t W_SB_OUT = W_SB_QKV + 6 * MiB;
constexpr size_t W_END = W_SB_OUT + 2 * MiB;
constexpr size_t WS_XB = 103 * MiB;
constexpr size_t WS_BIG = 168 * MiB;
constexpr size_t WS_NEED = 492 * MiB;
static_assert(W_END <= 102 * MiB, "weights map");
constexpr size_t BIG_GLA_KDT = 192 * MiB, BIG_GLA_EG = 224 * MiB, BIG_GLA_GLR = 225 * MiB, BIG_GLA_OPRE = 227 * MiB;
constexpr size_t BIG_SSD_DT = 320 * MiB;
constexpr size_t BIG_SB_AO = 192 * MiB;

typedef __bf16 bf2_t __attribute__((ext_vector_type(2)));
typedef float f2_t __attribute__((ext_vector_type(2)));
__device__ __forceinline__ unsigned cvt_pk_bf16(float lo, float hi) { f2_t v = {lo, hi}; bf2_t r = __builtin_convertvector(v, bf2_t); return __builtin_bit_cast(unsigned, r); }
__device__ __forceinline__ float bflo(unsigned w) { return __uint_as_float(w << 16); }
__device__ __forceinline__ float bfhi(unsigned w) { return __uint_as_float(w & 0xffff0000u); }
__device__ __forceinline__ float bf1(bf16_t h) { return __uint_as_float((unsigned)h << 16); }
__device__ __forceinline__ bf16_t f2bf(float f) { return (bf16_t)(cvt_pk_bf16(f, 0.f) & 0xffffu); }
__device__ __forceinline__ float fast_silu(float x) { return x * __builtin_amdgcn_rcpf(1.f + __expf(-x)); }
__device__ __forceinline__ float row_rstd(const float* rssp, int row) {
    const f32x4 a = *(const f32x4*)(rssp + (size_t)row * 4);
    const float s = (a.x + a.y) + (a.z + a.w);
    return rsqrtf(s * (1.0f / 1024.0f) + 1e-6f);
}
#define LBAR() do { asm volatile("s_waitcnt lgkmcnt(0)" ::: "memory"); __builtin_amdgcn_s_barrier(); asm volatile("" ::: "memory"); } while (0)
__device__ __forceinline__ int swz144(int r, int sb) { return r * 128 + ((((sb >> 4) ^ (((r >> 3) ^ (r >> 1)) & 7)) << 4) | (sb & 15)); }
#define MFMA16(a, b, c) __builtin_amdgcn_mfma_f32_16x16x32_bf16((a), (b), (c), 0, 0, 0)
__device__ __forceinline__ bf16x8 ldsfrag(const unsigned char* p) { return *(const bf16x8*)p; }

__device__ __forceinline__ float prev_lane16(float x) { const int v = __builtin_bit_cast(int, x); return __builtin_bit_cast(float, __builtin_amdgcn_update_dpp(v, v, 0x111  , 0xf, 0xf, false)); }
namespace pg8 {
constexpr int BM = 256, BK = 64, HALF = 128, HTB = HALF * BK * 2, STAGE_BYTES = 8 * HTB, NXCD = 8, WGM = 8;
__host__ __device__ __forceinline__ int lds_byte(int r, int c) { const int st = (r >> 4) * 2 + (c >> 5), rr = r & 15, cc = c & 31, ob = rr * 64 + cc * 2; return st * 1024 + (ob ^ (((ob >> 9) & 1) << 5)); }
__host__ __device__ __forceinline__ void stage_rc(int b, int& R, int& C) { const int st = b / 1024, sb = b % 1024, swz = sb ^ (((sb >> 9) & 1) << 5); R = (st >> 1) * 16 + swz / 64; C = (st & 1) * 32 + (swz % 64) / 2; }
__host__ __device__ __forceinline__ int perm32(int rho) { const int n = rho >> 4, i = rho & 15; return 8 * (i >> 2) + 4 * n + (i & 3); }

struct Unit { int pm, pn; long a_off, b_off; };

struct Sched {
    int nM, nN, nwg, G, c, mode; long a_tile, a_pn, b_tile;
    __device__ __forceinline__ void init(int nM_, int nN_, int G_, int c_, int mode_, long a_tile_, long a_pn_, long b_tile_) { nM = nM_; nN = nN_; nwg = nM * nN; G = G_; c = c_; mode = mode_; a_tile = a_tile_; a_pn = a_pn_; b_tile = b_tile_; }
    __device__ __forceinline__ bool next(int i, Unit& u) const {
        const long L = (long)i * G + c; if (L >= nwg) return false;
        int wgid = (int)L; { const int q = nwg / NXCD, r = nwg % NXCD, xcd = wgid % NXCD, off = wgid / NXCD; wgid = (xcd < r ? xcd * (q + 1) : r * (q + 1) + (xcd - r) * q) + off; }
        const int nig = WGM * nN, gid = wgid / nig, fm = gid * WGM, gsz = (nM - fm) < WGM ? (nM - fm) : WGM;
        u.pm = fm + ((wgid % nig) % gsz); u.pn = (wgid % nig) / gsz;
        if (mode == 0) u.a_off = (long)u.pm * a_tile + (long)u.pn * a_pn;
        else { const int b = u.pm / 17, ii = u.pm - b * 17; u.a_off = ((long)b * 4096 + 254 * ii - 2) * 2048; }
        u.b_off = (long)u.pn * b_tile; return true;
    }
};

struct EpiProj {
    static constexpr bool PERM = true, APERM = false;
    bf16_t* O; int ldc; const float* rssp; int sp_tile; float* sp_out; int sp_ld;
    __device__ __forceinline__ bool narrow(const Unit& u) const { return u.pn == sp_tile; }
    __device__ __forceinline__ void operator()(f32x4 (&acc)[2][2][4][2], const Unit& u, int wr, int wc, int fr, int fq, unsigned char* lds) const {
        const int row0 = u.pm * BM + wr * 64 + fr;
        float rs[2][4];
#pragma unroll
        for (int ai = 0; ai < 2; ++ai)
#pragma unroll
            for (int m = 0; m < 4; ++m) rs[ai][m] = row_rstd(rssp, row0 + ai * HALF + m * 16);
        if (u.pn == sp_tile) {
            if (wc == 0) {
#pragma unroll
                for (int ai = 0; ai < 2; ++ai)
#pragma unroll
                    for (int m = 0; m < 4; ++m)
#pragma unroll
                        for (int n = 0; n < 2; ++n) { const int c = 8 * fq + 4 * n; if (c < sp_ld) *(f32x4*)(sp_out + (size_t)(row0 + ai * HALF + m * 16) * sp_ld + c) = acc[ai][0][m][n] * rs[ai][m]; }
            }
            return;
        }
        const int col0 = u.pn * BM + wc * 32 + 8 * fq;
#pragma unroll
        for (int ai = 0; ai < 2; ++ai)
#pragma unroll
            for (int m = 0; m < 4; ++m) { bf16_t* rowp = O + (size_t)(row0 + ai * HALF + m * 16) * ldc + col0; const float s = rs[ai][m];
#pragma unroll
                for (int bj = 0; bj < 2; ++bj) { const f32x4 v0 = acc[ai][bj][m][0] * s, v1 = acc[ai][bj][m][1] * s;
                    u32x4 w; w.x = cvt_pk_bf16(v0[0], v0[1]); w.y = cvt_pk_bf16(v0[2], v0[3]); w.z = cvt_pk_bf16(v1[0], v1[1]); w.w = cvt_pk_bf16(v1[2], v1[3]);
                    *(u32x4*)(rowp + bj * HALF) = w; } }
    }
};

struct EpiSsdIn {
    static constexpr bool PERM = true, APERM = true;
    bf16_t* O; const float* rssp; float* dt_out; const float* cw; const float* cb; float* side;
    __device__ __forceinline__ bool narrow(const Unit& u) const { return u.pn == 20; }
    __device__ __forceinline__ void operator()(f32x4 (&acc)[2][2][4][2], const Unit& u, int wr, int wc, int fr, int fq, unsigned char* lds) const {
        const int ii = u.pm & 15; const int rowbase = u.pm * BM;
        float* bnd = (float*)(lds + STAGE_BYTES);
#pragma unroll
        for (int ai = 0; ai < 2; ++ai)
#pragma unroll
            for (int m = 0; m < 4; ++m) { const float rs = row_rstd(rssp, rowbase + ai * HALF + wr * 64 + 4 * fr + m);
#pragma unroll
                for (int bj = 0; bj < 2; ++bj)
#pragma unroll
                    for (int n = 0; n < 2; ++n) acc[ai][bj][m][n] = acc[ai][bj][m][n] * rs; }
        const bool convt = (u.pn >= 8 && u.pn < 20);
        if (convt) {
            const int xc0 = (u.pn - 8) * 256 + wc * 32 + 8 * fq;
            if (fr == 15) {
#pragma unroll
                for (int ai = 0; ai < 2; ++ai)
#pragma unroll
                    for (int mm = 0; mm < 3; ++mm)
#pragma unroll
                        for (int bj = 0; bj < 2; ++bj)
#pragma unroll
                            for (int n = 0; n < 2; ++n) *(f32x4*)(bnd + ((ai * 2 + wr) * 3 + mm) * 256 + bj * HALF + wc * 32 + 8 * fq + 4 * n) = acc[ai][bj][1 + mm][n];
                if (wr == 1) {
#pragma unroll
                    for (int mm = 0; mm < 3; ++mm)
#pragma unroll
                        for (int bj = 0; bj < 2; ++bj)
#pragma unroll
                            for (int n = 0; n < 2; ++n) *(f32x4*)(side + ((size_t)u.pm * 6 + 3 + mm) * 3072 + xc0 + bj * HALF + 4 * n) = acc[1][bj][1 + mm][n];
                }
            }
            if (fr == 0 && wr == 0) {
#pragma unroll
                for (int mm = 0; mm < 3; ++mm)
#pragma unroll
                    for (int bj = 0; bj < 2; ++bj)
#pragma unroll
                        for (int n = 0; n < 2; ++n) *(f32x4*)(side + ((size_t)u.pm * 6 + mm) * 3072 + xc0 + bj * HALF + 4 * n) = acc[0][bj][mm][n];
            }
        }
        asm volatile("s_waitcnt lgkmcnt(0)" ::: "memory"); __builtin_amdgcn_s_barrier(); asm volatile("" ::: "memory");
        if (convt) {
            const int xc0 = (u.pn - 8) * 256 + wc * 32 + 8 * fq;
#pragma unroll
            for (int bj = 0; bj < 2; ++bj)
#pragma unroll
                for (int n = 0; n < 2; ++n) { const int xc = xc0 + bj * HALF + 4 * n;
                    const f32x4 w0 = *(const f32x4*)(cw + xc), w1 = *(const f32x4*)(cw + 3072 + xc), w2 = *(const f32x4*)(cw + 2 * 3072 + xc), w3 = *(const f32x4*)(cw + 3 * 3072 + xc), bb = *(const f32x4*)(cb + xc);
#pragma unroll
                    for (int ai = 0; ai < 2; ++ai) { const int pblk = ai * 2 + wr - 1;
                        f32x4 p1, p2, p3;
#pragma unroll
                        for (int e = 0; e < 4; ++e) { p1[e] = prev_lane16(acc[ai][bj][1][n][e]); p2[e] = prev_lane16(acc[ai][bj][2][n][e]); p3[e] = prev_lane16(acc[ai][bj][3][n][e]); }
                        if (fr == 0) { if (pblk >= 0) { const float* bp = bnd + (pblk * 3) * 256 + bj * HALF + wc * 32 + 8 * fq + 4 * n; p1 = *(const f32x4*)(bp); p2 = *(const f32x4*)(bp + 256); p3 = *(const f32x4*)(bp + 512); }
                                       else { p1 = (f32x4){0.f, 0.f, 0.f, 0.f}; p2 = p1; p3 = p1; } }
                        const f32x4 v0 = acc[ai][bj][0][n], v1 = acc[ai][bj][1][n], v2 = acc[ai][bj][2][n], v3 = acc[ai][bj][3][n];
                        f32x4 o[4];
                        o[0] = bb + w3 * v0 + w2 * p3 + w1 * p2 + w0 * p1; o[1] = bb + w3 * v1 + w2 * v0 + w1 * p3 + w0 * p2;
                        o[2] = bb + w3 * v2 + w2 * v1 + w1 * v0 + w0 * p3; o[3] = bb + w3 * v3 + w2 * v2 + w1 * v1 + w0 * v0;
#pragma unroll
                        for (int m = 0; m < 4; ++m) { const int tau = ai * HALF + wr * 64 + 4 * fr + m;
                            if (tau >= 3 || ii == 0) { u32x2 w; w.x = cvt_pk_bf16(fast_silu(o[m][0]), fast_silu(o[m][1])); w.y = cvt_pk_bf16(fast_silu(o[m][2]), fast_silu(o[m][3]));
                                *(u32x2*)(O + (size_t)(rowbase + tau) * 5120 + 2048 + xc) = w; } } } }
        } else if (u.pn == 20) {
            if (wc == 0) {
#pragma unroll
                for (int ai = 0; ai < 2; ++ai)
#pragma unroll
                    for (int m = 0; m < 4; ++m)
#pragma unroll
                        for (int n = 0; n < 2; ++n) *(f32x4*)(dt_out + (size_t)(rowbase + ai * HALF + wr * 64 + 4 * fr + m) * 32 + 8 * fq + 4 * n) = acc[ai][0][m][n];
            }
        } else {
            const int col0 = u.pn * BM + wc * 32 + 8 * fq;
#pragma unroll
            for (int ai = 0; ai < 2; ++ai)
#pragma unroll
                for (int m = 0; m < 4; ++m) { bf16_t* rowp = O + (size_t)(rowbase + ai * HALF + wr * 64 + 4 * fr + m) * 5120 + col0;
#pragma unroll
                    for (int bj = 0; bj < 2; ++bj) { const f32x4 v0 = acc[ai][bj][m][0], v1 = acc[ai][bj][m][1];
                        u32x4 w; w.x = cvt_pk_bf16(v0[0], v0[1]); w.y = cvt_pk_bf16(v0[2], v0[3]); w.z = cvt_pk_bf16(v1[0], v1[1]); w.w = cvt_pk_bf16(v1[2], v1[3]);
                        *(u32x4*)(rowp + bj * HALF) = w; } }
        }
    }
};

struct EpiResid {
    static constexpr bool PERM = true, APERM = false;
    bf16_t* xb; float* rssp_out; const float* bias; const float* scale; int dry;
    __device__ __forceinline__ bool narrow(const Unit&) const { return false; }
    __device__ __forceinline__ void operator()(f32x4 (&acc)[2][2][4][2], const Unit& u, int wr, int wc, int fr, int fq, unsigned char* lds) const {
        const int col0 = u.pn * BM + wc * 32 + 8 * fq;
        float* part = (float*)(lds + STAGE_BYTES);
        if (bias) {
#pragma unroll
            for (int bj = 0; bj < 2; ++bj)
#pragma unroll
                for (int n = 0; n < 2; ++n) { const f32x4 bv = *(const f32x4*)(bias + col0 + bj * HALF + 4 * n), sv = *(const f32x4*)(scale + col0 + bj * HALF + 4 * n);
#pragma unroll
                    for (int ai = 0; ai < 2; ++ai)
#pragma unroll
                        for (int m = 0; m < 4; ++m) acc[ai][bj][m][n] = (acc[ai][bj][m][n] + bv) * sv; }
        }
#pragma unroll
        for (int ai = 0; ai < 2; ++ai) {
            u32x4 xo[4][2];
#pragma unroll
            for (int m = 0; m < 4; ++m)
#pragma unroll
                for (int bj = 0; bj < 2; ++bj) xo[m][bj] = *(const u32x4*)(xb + (size_t)(u.pm * BM + ai * HALF + wr * 64 + m * 16 + fr) * DM + col0 + bj * HALF);
#pragma unroll
            for (int m = 0; m < 4; ++m) { const int row = u.pm * BM + ai * HALF + wr * 64 + m * 16 + fr; bf16_t* rp = xb + (size_t)row * DM + col0; float ss = 0.f;
#pragma unroll
                for (int bj = 0; bj < 2; ++bj) { const u32x4 xv = xo[m][bj]; const f32x4 v0 = acc[ai][bj][m][0], v1 = acc[ai][bj][m][1];
                    const float x0 = bflo(xv.x) + v0[0], x1 = bfhi(xv.x) + v0[1], x2 = bflo(xv.y) + v0[2], x3 = bfhi(xv.y) + v0[3];
                    const float x4 = bflo(xv.z) + v1[0], x5 = bfhi(xv.z) + v1[1], x6 = bflo(xv.w) + v1[2], x7 = bfhi(xv.w) + v1[3];
                    ss += ((x0 * x0 + x1 * x1) + (x2 * x2 + x3 * x3)) + ((x4 * x4 + x5 * x5) + (x6 * x6 + x7 * x7));
                    u32x4 w; w.x = cvt_pk_bf16(x0, x1); w.y = cvt_pk_bf16(x2, x3); w.z = cvt_pk_bf16(x4, x5); w.w = cvt_pk_bf16(x6, x7);
                    if (!dry) *(u32x4*)(rp + bj * HALF) = w; }
                ss += __shfl_xor(ss, 16); ss += __shfl_xor(ss, 32);
                if (fq == 0) part[wc * 256 + ai * HALF + wr * 64 + m * 16 + fr] = ss; }
        }
        asm volatile("s_waitcnt lgkmcnt(0)" ::: "memory"); __builtin_amdgcn_s_barrier(); asm volatile("" ::: "memory");
        { const int t = (wr * 4 + wc) * 64 + fq * 16 + fr;
          if (t < 256 && !dry) rssp_out[(size_t)(u.pm * BM + t) * 4 + u.pn] = (part[t] + part[256 + t]) + (part[512 + t] + part[768 + t]); }
    }
};

struct EpiFfnUp {
    static constexpr bool PERM = true, APERM = true;
    bf16_t* act; const float* rssp; const float* cw; const float* cb; float* side;
    __device__ __forceinline__ bool narrow(const Unit&) const { return false; }
    __device__ __forceinline__ void operator()(f32x4 (&acc)[2][2][4][2], const Unit& u, int wr, int wc, int fr, int fq, unsigned char* lds) const {
        const int ii = u.pm & 15; const int rowbase = u.pm * BM;
        float* bnd = (float*)(lds + STAGE_BYTES);
        const int ch0 = u.pn * 128 + wc * 32 + 8 * fq;
        f32x4 wq[8];
        wq[0] = *(const f32x4*)(cw + ch0); wq[1] = *(const f32x4*)(cw + 5632 + ch0); wq[2] = *(const f32x4*)(cw + 2 * 5632 + ch0); wq[3] = *(const f32x4*)(cb + ch0);
        wq[4] = *(const f32x4*)(cw + FFD + ch0); wq[5] = *(const f32x4*)(cw + 5632 + FFD + ch0); wq[6] = *(const f32x4*)(cw + 2 * 5632 + FFD + ch0); wq[7] = *(const f32x4*)(cb + FFD + ch0);
#pragma unroll
        for (int ai = 0; ai < 2; ++ai)
#pragma unroll
            for (int m = 0; m < 4; ++m) { const float rs = row_rstd(rssp, rowbase + ai * HALF + wr * 64 + 4 * fr + m);
#pragma unroll
                for (int bj = 0; bj < 2; ++bj)
#pragma unroll
                    for (int n = 0; n < 2; ++n) acc[ai][bj][m][n] = acc[ai][bj][m][n] * rs; }
        if (fr == 15) {
#pragma unroll
            for (int ai = 0; ai < 2; ++ai)
#pragma unroll
                for (int mm = 0; mm < 2; ++mm)
#pragma unroll
                    for (int bj = 0; bj < 2; ++bj)
#pragma unroll
                        for (int n = 0; n < 2; ++n) *(f32x4*)(bnd + ((ai * 2 + wr) * 2 + mm) * 256 + bj * HALF + wc * 32 + 8 * fq + 4 * n) = acc[ai][bj][2 + mm][n];
            if (wr == 1) {
#pragma unroll
                for (int mm = 0; mm < 2; ++mm)
#pragma unroll
                    for (int bj = 0; bj < 2; ++bj)
#pragma unroll
                        for (int n = 0; n < 2; ++n) *(f32x4*)(side + ((size_t)u.pm * 4 + 2 + mm) * 5632 + u.pn * 256 + bj * HALF + wc * 32 + 8 * fq + 4 * n) = acc[1][bj][2 + mm][n];
            }
        }
        if (fr == 0 && wr == 0) {
#pragma unroll
            for (int mm = 0; mm < 2; ++mm)
#pragma unroll
                for (int bj = 0; bj < 2; ++bj)
#pragma unroll
                    for (int n = 0; n < 2; ++n) *(f32x4*)(side + ((size_t)u.pm * 4 + mm) * 5632 + u.pn * 256 + bj * HALF + wc * 32 + 8 * fq + 4 * n) = acc[0][bj][mm][n];
        }
        asm volatile("s_waitcnt lgkmcnt(0)" ::: "memory"); __builtin_amdgcn_s_barrier(); asm volatile("" ::: "memory");
#pragma unroll
        for (int n = 0; n < 2; ++n) {
            if (n == 1) { wq[0] = *(const f32x4*)(cw + ch0 + 4); wq[1] = *(const f32x4*)(cw + 5632 + ch0 + 4); wq[2] = *(const f32x4*)(cw + 2 * 5632 + ch0 + 4); wq[3] = *(const f32x4*)(cb + ch0 + 4);
                          wq[4] = *(const f32x4*)(cw + FFD + ch0 + 4); wq[5] = *(const f32x4*)(cw + 5632 + FFD + ch0 + 4); wq[6] = *(const f32x4*)(cw + 2 * 5632 + FFD + ch0 + 4); wq[7] = *(const f32x4*)(cb + FFD + ch0 + 4); }
#pragma unroll
            for (int ai = 0; ai < 2; ++ai) {
                const int pblk = ai * 2 + wr - 1;
                float outv[4][4];
                {
                const f32x4 w0g = wq[0], w1g = wq[1], w2g = wq[2], bg = wq[3];
                f32x4 p2g, p3g;
#pragma unroll
                for (int e = 0; e < 4; ++e) { p2g[e] = prev_lane16(acc[ai][0][2][n][e]); p3g[e] = prev_lane16(acc[ai][0][3][n][e]); }
                if (fr == 0) { if (pblk >= 0) { const float* bp = bnd + (pblk * 2) * 256 + wc * 32 + 8 * fq + 4 * n; p2g = *(const f32x4*)(bp); p3g = *(const f32x4*)(bp + 256); } else { p2g = (f32x4){0.f, 0.f, 0.f, 0.f}; p3g = p2g; } }
                const f32x4 g0 = acc[ai][0][0][n], g1 = acc[ai][0][1][n], g2 = acc[ai][0][2][n], g3 = acc[ai][0][3][n];
                const f32x4 cg0 = bg + w2g * g0 + w1g * p3g + w0g * p2g, cg1 = bg + w2g * g1 + w1g * g0 + w0g * p3g, cg2 = bg + w2g * g2 + w1g * g1 + w0g * g0, cg3 = bg + w2g * g3 + w1g * g2 + w0g * g1;
#pragma unroll
                for (int e = 0; e < 4; ++e) { outv[0][e] = fast_silu(cg0[e]); outv[1][e] = fast_silu(cg1[e]); outv[2][e] = fast_silu(cg2[e]); outv[3][e] = fast_silu(cg3[e]); }
                }
                {
                const f32x4 w0v = wq[4], w1v = wq[5], w2v = wq[6], bv = wq[7];
                f32x4 p2v, p3v;
#pragma unroll
                for (int e = 0; e < 4; ++e) { p2v[e] = prev_lane16(acc[ai][1][2][n][e]); p3v[e] = prev_lane16(acc[ai][1][3][n][e]); }
                if (fr == 0) { if (pblk >= 0) { const float* bp = bnd + (pblk * 2) * 256 + HALF + wc * 32 + 8 * fq + 4 * n; p2v = *(const f32x4*)(bp); p3v = *(const f32x4*)(bp + 256); } else { p2v = (f32x4){0.f, 0.f, 0.f, 0.f}; p3v = p2v; } }
                const f32x4 v0 = acc[ai][1][0][n], v1 = acc[ai][1][1][n], v2 = acc[ai][1][2][n], v3 = acc[ai][1][3][n];
                const f32x4 cv0 = bv + w2v * v0 + w1v * p3v + w0v * p2v, cv1 = bv + w2v * v1 + w1v * v0 + w0v * p3v, cv2 = bv + w2v * v2 + w1v * v1 + w0v * v0, cv3 = bv + w2v * v3 + w1v * v2 + w0v * v1;
#pragma unroll
                for (int e = 0; e < 4; ++e) { outv[0][e] *= cv0[e]; outv[1][e] *= cv1[e]; outv[2][e] *= cv2[e]; outv[3][e] *= cv3[e]; }
                }
#pragma unroll
                for (int m = 0; m < 4; ++m) { const int tau = ai * HALF + wr * 64 + 4 * fr + m;
                    if (tau >= 2 || ii == 0) { u32x2 w; w.x = cvt_pk_bf16(outv[m][0], outv[m][1]); w.y = cvt_pk_bf16(outv[m][2], outv[m][3]);
                        *(u32x2*)(act + ((size_t)((ch0 + 4 * n) >> 6) * NTOK + (rowbase + tau)) * 64 + ((ch0 + 4 * n) & 63)) = w; } }
            }
        }
    }
};

template <class Epi>
__device__ __forceinline__ void gemm_phase(unsigned char* lds_g, const bf16_t* Ag, const bf16_t* Btg, int lda, int K, const Sched& S, const Epi& E, int tid, size_t kstepA = 128) {
    LAS unsigned char* lds = (LAS unsigned char*)lds_g;
    const int wid = __builtin_amdgcn_readfirstlane(tid >> 6), lane = tid & 63, wr = wid >> 2, wc = wid & 3, fr = lane & 15, fq = lane >> 4;
    const int nt = K / BK;
    unsigned voffA[2], voffB[2];
#pragma unroll
    for (int i = 0; i < 2; ++i) { int R, C; stage_rc(tid * 16 + i * 8192, R, C);
        const int Rb = Epi::PERM ? ((R & ~31) + perm32(R & 31)) : R;
        const int Ra = Epi::APERM ? ((R & 64) + 4 * (R & 15) + ((R >> 4) & 3)) : R;
        voffA[i] = (unsigned)(Ra * lda + C) * 2u; voffB[i] = (unsigned)(Rb * K + C) * 2u; }
    const size_t kstep = (size_t)(BK * 2);
    const size_t hstepA = (size_t)HALF * lda * 2, hstepB = (size_t)HALF * K * 2;
    const unsigned ldsw = (unsigned)wid * 1024u;
    const int aoff = lds_byte(wr * 64 + fr, fq * 8), boff = lds_byte(wc * 32 + fr, fq * 8);
#define PG8_SA(b, h) (((b) * 2 + (h)) * HTB)
#define PG8_SB(b, h) ((4 + (b) * 2 + (h)) * HTB)
#define PG8_STAGE(bufoff, gbase, voff) do { _Pragma("unroll") for (int _i = 0; _i < 2; ++_i) \
        __builtin_amdgcn_global_load_lds((const unsigned*)((const char*)(gbase) + (voff)[_i]), (LAS unsigned*)(lds + (bufoff) + ldsw + _i * 8192), 16, 0, 0); } while (0)
#define PG8_LDA(dst, b, h) do { _Pragma("unroll") for (int m = 0; m < 4; ++m) _Pragma("unroll") for (int k = 0; k < 2; ++k) dst[m][k] = *(const LAS bf16x8*)(lds + PG8_SA(b, h) + aoff + m * 2048 + k * 1024); } while (0)
#define PG8_LDB(dst, b, h) do { _Pragma("unroll") for (int n = 0; n < 2; ++n) _Pragma("unroll") for (int k = 0; k < 2; ++k) dst[n][k] = *(const LAS bf16x8*)(lds + PG8_SB(b, h) + boff + n * 2048 + k * 1024); } while (0)
#define PG8_MMA(ai, bj, At, Bt) do { __builtin_amdgcn_s_setprio(1); _Pragma("unroll") for (int m = 0; m < 4; ++m) _Pragma("unroll") for (int n = 0; n < 2; ++n) _Pragma("unroll") for (int k = 0; k < 2; ++k) \
        acc[ai][bj][m][n] = __builtin_amdgcn_mfma_f32_16x16x32_bf16(Bt[n][k], At[m][k], acc[ai][bj][m][n], 0, 0, 0); __builtin_amdgcn_s_setprio(0); } while (0)
#define PG8_WAIT_V(n) asm volatile("s_waitcnt vmcnt(" #n ")" ::: "memory")
#define PG8_WAIT_L(n) asm volatile("s_waitcnt lgkmcnt(" #n ")" ::: "memory")
#define PG8_BAR __builtin_amdgcn_s_barrier()
#define PG8_SCHED __builtin_amdgcn_sched_barrier(0)
    Unit cur, nxt; int ui = 0;
    if (!S.next(0, cur)) return;
    f32x4 acc[2][2][4][2];
#pragma unroll
    for (int a = 0; a < 2; ++a)
#pragma unroll
        for (int b = 0; b < 2; ++b)
#pragma unroll
            for (int m = 0; m < 4; ++m)
#pragma unroll
                for (int n = 0; n < 2; ++n) acc[a][b][m][n] = (f32x4){0.f, 0.f, 0.f, 0.f};
    bf16x8 At[4][2], B0[2][2], B1[2][2];
    const char* cA = (const char*)Ag + cur.a_off; const char* cB = (const char*)Btg + cur.b_off;
    PG8_STAGE(PG8_SB(0, 0), cB, voffB); PG8_STAGE(PG8_SB(0, 1), cB + hstepB, voffB); PG8_STAGE(PG8_SA(0, 0), cA, voffA); PG8_STAGE(PG8_SA(0, 1), cA + hstepA, voffA);
    if (wr == 1) PG8_BAR;
    PG8_WAIT_V(2); PG8_BAR;
    PG8_STAGE(PG8_SB(1, 0), cB + kstep, voffB); PG8_STAGE(PG8_SA(1, 0), cA + kstepA, voffA); PG8_STAGE(PG8_SB(1, 1), cB + hstepB + kstep, voffB);
    PG8_WAIT_V(6); PG8_BAR;
    for (;;) {
        const bool narrow = E.narrow(cur);
        const bool has_next = S.next(ui + 1, nxt);
        const char* nA = has_next ? (const char*)Ag + nxt.a_off : cA; const char* nB = has_next ? (const char*)Btg + nxt.b_off : cB;
        for (int t = 0; t < nt; t += 2) {
            const bool last = (t == nt - 2);
            const char* a1 = cA + (size_t)(t + 1) * kstepA;
            const char* a2 = last ? nA : cA + (size_t)(t + 2) * kstepA; const char* b2 = last ? nB : cB + (size_t)(t + 2) * kstep;
            const char* a3 = a2 + kstepA; const char* b3 = b2 + kstep;
            PG8_LDB(B0, 0, 0); PG8_LDB(B1, 0, 1); PG8_SCHED; PG8_LDA(At, 0, 0); PG8_STAGE(PG8_SA(1, 1), a1 + hstepA, voffA);
            PG8_WAIT_V(8); PG8_WAIT_L(0); PG8_BAR; PG8_MMA(0, 0, At, B0); if (!narrow) PG8_MMA(0, 1, At, B1); PG8_BAR; PG8_SCHED;
            PG8_LDA(At, 0, 1); PG8_STAGE(PG8_SB(0, 0), b2, voffB); PG8_STAGE(PG8_SB(0, 1), b2 + hstepB, voffB); PG8_STAGE(PG8_SA(0, 0), a2, voffA);
            PG8_WAIT_V(8); PG8_WAIT_L(0); PG8_BAR; PG8_MMA(1, 0, At, B0); if (!narrow) PG8_MMA(1, 1, At, B1); PG8_BAR; PG8_SCHED;
            PG8_LDB(B0, 1, 0); PG8_LDB(B1, 1, 1); PG8_SCHED; PG8_LDA(At, 1, 0); PG8_STAGE(PG8_SA(0, 1), a2 + hstepA, voffA);
            PG8_WAIT_V(8); PG8_WAIT_L(0); PG8_BAR; PG8_MMA(0, 0, At, B0); if (!narrow) PG8_MMA(0, 1, At, B1); PG8_BAR; PG8_SCHED;
            PG8_LDA(At, 1, 1); PG8_STAGE(PG8_SB(1, 0), b3, voffB); PG8_STAGE(PG8_SB(1, 1), b3 + hstepB, voffB); PG8_STAGE(PG8_SA(1, 0), a3, voffA);
            PG8_WAIT_V(8); PG8_WAIT_L(0); PG8_BAR; PG8_MMA(1, 0, At, B0); if (!narrow) PG8_MMA(1, 1, At, B1); PG8_BAR; PG8_SCHED;
        }
        if (wr == 0) PG8_BAR;
        E(acc, cur, wr, wc, fr, fq, lds_g);
        if (!has_next) break;
#pragma unroll
        for (int a = 0; a < 2; ++a)
#pragma unroll
            for (int b = 0; b < 2; ++b)
#pragma unroll
                for (int m = 0; m < 4; ++m)
#pragma unroll
                    for (int n = 0; n < 2; ++n) acc[a][b][m][n] = (f32x4){0.f, 0.f, 0.f, 0.f};
        cur = nxt; cA = nA; cB = nB; ++ui;
        if (wr == 1) PG8_BAR;
    }
    PG8_WAIT_V(0);
    PG8_BAR;
#undef PG8_SA
#undef PG8_SB
#undef PG8_STAGE
#undef PG8_LDA
#undef PG8_LDB
#undef PG8_MMA
#undef PG8_WAIT_V
#undef PG8_WAIT_L
#undef PG8_BAR
#undef PG8_SCHED
}
}

struct Params { const float* in[26]; float* out; unsigned char* ws; };
enum { I_X = 0, I_MIXNW, I_FFNNW, I_FINNW, I_GLA_WIN, I_GLA_WG2, I_GLA_BG, I_GLA_NW, I_GLA_WOUT, I_POOL_W, I_POOL_B, I_POOL_SC,
       I_SSD_WIN, I_SSD_CW, I_SSD_CB, I_SSD_DTB, I_SSD_ALOG, I_SSD_D, I_SSD_NW, I_SSD_WOUT, I_SB_WQKV, I_SB_WOUT, I_FFN_WUP, I_FFN_CW, I_FFN_CB, I_FFN_WDOWN };

struct TrItem { const float* W; int K, N; bf16_t* dst; int drow, n0, k0; const float* ks; float cs; };
__device__ __forceinline__ void tr_load(const TrItem& t, float (&v)[64], int lane) {
    const int n = t.n0 + lane; const bool ok = n < t.N;
#pragma unroll
    for (int kk = 0; kk < 64; ++kk) v[kk] = ok ? __builtin_nontemporal_load(t.W + (size_t)(t.k0 + kk) * t.N + n) : 0.f;
}
__device__ __forceinline__ void tr_store(const TrItem& t, const float (&v)[64], float* scr, int lane) {
#pragma unroll
    for (int kk = 0; kk < 64; ++kk) { float x = v[kk]; if (t.ks) x *= t.ks[t.k0 + kk]; scr[kk * 65 + lane] = x * t.cs; }
    asm volatile("s_waitcnt lgkmcnt(0)" ::: "memory");
    const int c = lane & 7;
#pragma unroll
    for (int j = 0; j < 8; ++j) { const int nn = (lane >> 3) + 8 * j; const float* s = scr + (8 * c) * 65 + nn;
        u32x4 o; o.x = cvt_pk_bf16(s[0], s[65]); o.y = cvt_pk_bf16(s[2 * 65], s[3 * 65]); o.z = cvt_pk_bf16(s[4 * 65], s[5 * 65]); o.w = cvt_pk_bf16(s[6 * 65], s[7 * 65]);
        __builtin_nontemporal_store(o, (u32x4*)(t.dst + (size_t)(t.drow + nn) * t.K + t.k0 + 8 * c)); }
    asm volatile("s_waitcnt lgkmcnt(0)" ::: "memory");
}
constexpr int I_UP = 16 * 88, I_DOWN = 44 * 16, I_GIN = 16 * 52, I_SQ = 16 * 16, I_POOLG = 4 * 4, I_SIN = 16 * 84, I_SOUT = 32 * 16, I_QKV = 16 * 48;
constexpr int NITEMS = 4 * I_UP + 4 * I_DOWN + I_GIN + I_SQ + 4 * I_POOLG + I_SIN + I_SOUT + I_QKV + I_SQ;
__device__ __forceinline__ TrItem tr_desc(const Params& p, int it) {
    unsigned char* ws = p.ws; int r = it;
    if (r < 4 * I_UP) { const int l = r / I_UP; r -= l * I_UP; const int kb = r / 88, nb = r % 88; const int n0 = nb * 64; const int half = n0 / FFD, cidx = n0 - half * FFD; const int drow = (cidx >> 7) * 256 + half * 128 + (cidx & 127);
        return TrItem{p.in[I_FFN_WUP] + (size_t)l * 1024 * 5632, 1024, 5632, (bf16_t*)(ws + WS_W + l * W_FFN_STRIDE), drow, n0, kb * 64, p.in[I_FFNNW] + l * 1024, 1.f}; } r -= 4 * I_UP;
    if (r < 4 * I_DOWN) { const int l = r / I_DOWN; r -= l * I_DOWN; const int kb = r / 16, nb = r % 16;
        return TrItem{p.in[I_FFN_WDOWN] + (size_t)l * FFD * 1024, FFD, 1024, (bf16_t*)(ws + WS_W + l * W_FFN_STRIDE + W_FFN_DOWN_OFF), nb * 64, nb * 64, kb * 64, nullptr, 1.f}; } r -= 4 * I_DOWN;
    if (r < I_GIN) { const int kb = r / 52, nb = r % 52; const int n0 = nb * 64;
        return TrItem{p.in[I_GLA_WIN], 1024, 3088, (bf16_t*)(ws + W_GLA_IN), n0, n0, kb * 64, p.in[I_MIXNW], n0 < 512 ? 0.08838834764831845f : 1.f}; } r -= I_GIN;
    if (r < I_SQ) { const int kb = r / 16, nb = r % 16;
        return TrItem{p.in[I_GLA_WOUT], 1024, 1024, (bf16_t*)(ws + W_GLA_OUT), nb * 64, nb * 64, kb * 64, nullptr, 1.f}; } r -= I_SQ;
    if (r < 4 * I_POOLG) { const int g = r / I_POOLG; r -= g * I_POOLG; const int kb = r / 4, nb = r % 4;
        return TrItem{p.in[I_POOL_W] + (size_t)g * 65536, 256, 256, (bf16_t*)(ws + W_POOL) + (size_t)g * 65536, nb * 64, nb * 64, kb * 64, nullptr, 1.f}; } r -= 4 * I_POOLG;
    if (r < I_SIN) { const int kb = r / 84, nb = r % 84; const int n0 = nb * 64;
        return TrItem{p.in[I_SSD_WIN], 1024, 5152, (bf16_t*)(ws + W_SSD_IN), n0, n0, kb * 64, p.in[I_MIXNW] + 2 * 1024, 1.f}; } r -= I_SIN;
    if (r < I_SOUT) { const int kb = r / 16, nb = r % 16;
        return TrItem{p.in[I_SSD_WOUT], 2048, 1024, (bf16_t*)(ws + W_SSD_OUT), nb * 64, nb * 64, kb * 64, p.in[I_SSD_NW], 1.f}; } r -= I_SOUT;
    if (r < I_QKV) { const int kb = r / 48, nb = r % 48; const int n0 = nb * 64;
        return TrItem{p.in[I_SB_WQKV], 1024, 3072, (bf16_t*)(ws + W_SB_QKV), n0, n0, kb * 64, p.in[I_MIXNW] + 3 * 1024, n0 < 1024 ? 0.125f * 1.4426950408889634f : 1.f}; } r -= I_QKV;
    { const int kb = r / 16, nb = r % 16;
        return TrItem{p.in[I_SB_WOUT], 1024, 1024, (bf16_t*)(ws + W_SB_OUT), nb * 64, nb * 64, kb * 64, nullptr, 1.f}; }
}

__device__ __forceinline__ void prep_phase(const Params& p, unsigned char* lds, int gw, int NGW, int wave, int lane) {
    float* scr = (float*)(lds + wave * 16640);
    unsigned char* ws = p.ws;
    for (int it = gw; it < NITEMS; it += 2 * NGW) {
        const TrItem ta = tr_desc(p, it); const bool hasb = (it + NGW) < NITEMS; const TrItem tb = tr_desc(p, hasb ? it + NGW : it);
        float va[64], vb[64];
        tr_load(ta, va, lane); if (hasb) tr_load(tb, vb, lane);
        tr_store(ta, va, scr, lane); if (hasb) tr_store(tb, vb, scr, lane);
    }
    const float* x = p.in[I_X]; bf16_t* XB = (bf16_t*)(ws + WS_XB); float* rssp = (float*)(ws + WS_RSSP);
    for (int m0 = gw * 4; m0 < NTOK; m0 += NGW * 4) {
        f32x4 v[4][4];
#pragma unroll
        for (int r = 0; r < 4; ++r)
#pragma unroll
            for (int j = 0; j < 4; ++j) v[r][j] = __builtin_nontemporal_load((const f32x4*)(x + (size_t)(m0 + r) * DM) + lane + 64 * j);
#pragma unroll
        for (int r = 0; r < 4; ++r) { float s = 0.f; unsigned long long* o8 = (unsigned long long*)(XB + (size_t)(m0 + r) * DM) + lane;
#pragma unroll
            for (int j = 0; j < 4; ++j) { const f32x4 t = v[r][j]; s += (t.x * t.x + t.y * t.y) + (t.z * t.z + t.w * t.w);
                o8[64 * j] = (unsigned long long)cvt_pk_bf16(t.x, t.y) | ((unsigned long long)cvt_pk_bf16(t.z, t.w) << 32); }
            s += __shfl_xor(s, 1); s += __shfl_xor(s, 2); s += __shfl_xor(s, 4); s += __shfl_xor(s, 8);
            if ((lane & 15) == 0) rssp[(size_t)(m0 + r) * 4 + (lane >> 4)] = s; }
    }
}

__device__ __forceinline__ void gla1_phase(const Params& p, unsigned char* lds, int bid, int G, int tid) {
    unsigned char* ws = p.ws;
    const bf16_t* P = (const bf16_t*)(ws + WS_BIG); const float* GLR = (const float*)(ws + WS_BIG + BIG_GLA_GLR);
    bf16_t* KDT = (bf16_t*)(ws + WS_BIG + BIG_GLA_KDT); float* EG = (float*)(ws + WS_BIG + BIG_GLA_EG); bf16_t* VT = (bf16_t*)p.out;
    float* glr_s = (float*)lds;
    float* wg_s = (float*)(lds + 4096);
    float* bg_s = (float*)(lds + 12288);
    float* tot_s = (float*)(lds + 12800);
    unsigned char* vt_s = lds + 16384;
    const float* wg2 = p.in[I_GLA_WG2]; const float* bgate = p.in[I_GLA_BG];
    for (int it = bid; it < 2048; it += G) {
        const int h = it & 3, c = (it >> 2) & 63, b = it >> 8; const int row0 = b * SEQL + c * 64;
        __syncthreads();
        for (int e = tid; e < 1024; e += 512) glr_s[e] = GLR[(size_t)(row0 + (e >> 4)) * 16 + (e & 15)];
        for (int e = tid; e < 2048; e += 512) wg_s[e] = wg2[(e >> 7) * 512 + h * 128 + (e & 127)];
        if (tid < 128) bg_s[tid] = bgate[h * 128 + tid];
        for (int e = tid; e < 2048; e += 512) { const int s = e >> 5, part = e & 31; *(u32x4*)(vt_s + s * 528 + part * 16) = *(const u32x4*)(P + (size_t)(row0 + s) * 3072 + 1024 + h * 256 + part * 8); }
        __syncthreads();
        const int k = tid & 127, sg = tid >> 7;
        float w[16];
#pragma unroll
        for (int j = 0; j < 16; ++j) w[j] = wg_s[j * 128 + k];
        const float bgk = bg_s[k];
        float gl[16]; float run = 0.f;
#pragma unroll
        for (int i = 0; i < 16; ++i) { const float* gr = glr_s + (sg * 16 + i) * 16; float pre = bgk;
#pragma unroll
            for (int j = 0; j < 16; ++j) pre += gr[j] * w[j];
            const float ls = fminf(pre, 0.f) - log1pf(expf(-fabsf(pre)));
            run += ls * (1.0f / 16.0f); gl[i] = run; }
        tot_s[sg * 128 + k] = run;
        __syncthreads();
        float off = 0.f, gend = 0.f;
#pragma unroll
        for (int g2 = 0; g2 < 4; ++g2) { const float tv = tot_s[g2 * 128 + k]; if (g2 < sg) off += tv; gend += tv; }
        unsigned pk[8];
#pragma unroll
        for (int i = 0; i < 16; i += 2) {
            const float k0 = bf1(P[(size_t)(row0 + sg * 16 + i) * 3072 + 512 + h * 128 + k]) * expf(gend - (off + gl[i]));
            const float k1 = bf1(P[(size_t)(row0 + sg * 16 + i + 1) * 3072 + 512 + h * 128 + k]) * expf(gend - (off + gl[i + 1]));
            pk[i >> 1] = cvt_pk_bf16(k0, k1); }
        u32x4* kd = (u32x4*)(KDT + (size_t)it * 8192 + k * 64 + sg * 16);
        kd[0] = (u32x4){pk[0], pk[1], pk[2], pk[3]}; kd[1] = (u32x4){pk[4], pk[5], pk[6], pk[7]};
        if (sg == 0) EG[(size_t)it * 128 + k] = expf(gend);
        { const int v = tid & 255, sh = tid >> 8; unsigned q[16];
#pragma unroll
            for (int i = 0; i < 16; ++i) { const unsigned lo = *(const bf16_t*)(vt_s + (sh * 32 + 2 * i) * 528 + v * 2), hi = *(const bf16_t*)(vt_s + (sh * 32 + 2 * i + 1) * 528 + v * 2); q[i] = lo | (hi << 16); }
            u32x4* vo = (u32x4*)(VT + (size_t)it * 16384 + v * 64 + sh * 32);
            vo[0] = (u32x4){q[0], q[1], q[2], q[3]}; vo[1] = (u32x4){q[4], q[5], q[6], q[7]}; vo[2] = (u32x4){q[8], q[9], q[10], q[11]}; vo[3] = (u32x4){q[12], q[13], q[14], q[15]}; }
    }
}

constexpr size_t BIG_GLA_SLOC = 292 * MiB, BIG_GLA_DSEG = 291 * MiB;
__device__ __forceinline__ void gla_scan_phase(const Params& p, unsigned char* lds, int bid, int G, int tid, int wave, int lane, const int MODE) {
    unsigned char* ws = p.ws;
    const bf16_t* P = (const bf16_t*)(ws + WS_BIG);
    const bf16_t* KDT = (const bf16_t*)(ws + WS_BIG + BIG_GLA_KDT); const float* EG = (const float*)(ws + WS_BIG + BIG_GLA_EG); const bf16_t* VT = (const bf16_t*)p.out;
    bf16_t* OPRE = (bf16_t*)(ws + WS_BIG + BIG_GLA_OPRE); float* SLOC = (float*)(ws + WS_BIG + BIG_GLA_SLOC); float* DSEG = (float*)(ws + WS_BIG + BIG_GLA_DSEG);
    unsigned char* KD = lds;
    unsigned char* VTs = lds + 18432;
    unsigned char* Qs = lds + 55296;
    unsigned char* ST = lds + 72704;
    float* eg_s = (float*)(lds + 142336);
    const int fr = lane & 15, fq = lane >> 4;
    for (int u = bid; u < 256; u += G) {
        const int seg = u & 7, bh = u >> 3, b = bh >> 2, h = bh & 3;
        if (MODE == 1 && seg == 7) continue;
        f32x4 S[16]; f32x4 dprod = (f32x4){1.f, 1.f, 1.f, 1.f};
        float* sl = SLOC + (size_t)u * 32768;
#pragma unroll
        for (int j = 0; j < 16; ++j) { if (MODE == 2) S[j] = *(const f32x4*)(sl + (16 * j + fr) * 128 + 16 * wave + 4 * fq); else S[j] = (f32x4){0.f, 0.f, 0.f, 0.f}; }
        u32x4 pk[2], pv[4], pq[2]; float peg = 0.f;
#define GLA_LOAD(cc) do { const int it_ = (b * 64 + (cc)) * 4 + h; const int r0_ = b * SEQL + (cc) * 64; \
            _Pragma("unroll") for (int i_ = 0; i_ < 2; ++i_) pk[i_] = *(const u32x4*)(KDT + (size_t)it_ * 8192 + (tid + 512 * i_) * 8); \
            _Pragma("unroll") for (int i_ = 0; i_ < 4; ++i_) pv[i_] = *(const u32x4*)(VT + (size_t)it_ * 16384 + (tid + 512 * i_) * 8); \
            if (MODE == 2) { _Pragma("unroll") for (int i_ = 0; i_ < 2; ++i_) { const int e_ = tid + 512 * i_; pq[i_] = *(const u32x4*)(P + (size_t)(r0_ + (e_ >> 4)) * 3072 + h * 128 + (e_ & 15) * 8); } } \
            if (tid < 128) peg = EG[(size_t)it_ * 128 + tid]; } while (0)
        GLA_LOAD(seg * 8);
        for (int c = seg * 8; c < seg * 8 + 8; ++c) {
            const int row0 = b * SEQL + c * 64;
            LBAR();
#pragma unroll
            for (int i = 0; i < 2; ++i) { const int e = tid + 512 * i; *(u32x4*)(KD + (e >> 3) * 144 + (e & 7) * 16) = pk[i]; }
#pragma unroll
            for (int i = 0; i < 4; ++i) { const int e = tid + 512 * i; *(u32x4*)(VTs + (e >> 3) * 144 + (e & 7) * 16) = pv[i]; }
            if (MODE == 2) {
#pragma unroll
                for (int i = 0; i < 2; ++i) { const int e = tid + 512 * i; *(u32x4*)(Qs + (e >> 4) * 272 + (e & 15) * 16) = pq[i]; } }
            if (tid < 128) eg_s[tid] = peg;
            if (c + 1 < seg * 8 + 8) GLA_LOAD(c + 1);
            LBAR();
            { const f32x4 ev = *(const f32x4*)(eg_s + 16 * wave + 4 * fq); dprod = dprod * ev;
              const bf16x8 a0 = ldsfrag(KD + (16 * wave + fr) * 144 + fq * 16), a1 = ldsfrag(KD + (16 * wave + fr) * 144 + 64 + fq * 16);
#pragma unroll
              for (int j4 = 0; j4 < 16; j4 += 4) { bf16x8 vb0[4], vb1[4];
#pragma unroll
                  for (int jj = 0; jj < 4; ++jj) { vb0[jj] = ldsfrag(VTs + (16 * (j4 + jj) + fr) * 144 + fq * 16); vb1[jj] = ldsfrag(VTs + (16 * (j4 + jj) + fr) * 144 + 64 + fq * 16); }
#pragma unroll
                  for (int jj = 0; jj < 4; ++jj) S[j4 + jj] = S[j4 + jj] * ev;
#pragma unroll
                  for (int jj = 0; jj < 4; ++jj) S[j4 + jj] = MFMA16(a0, vb0[jj], S[j4 + jj]);
#pragma unroll
                  for (int jj = 0; jj < 4; ++jj) S[j4 + jj] = MFMA16(a1, vb1[jj], S[j4 + jj]);
                  if (MODE == 2) {
#pragma unroll
                      for (int jj = 0; jj < 4; ++jj) { const int j = j4 + jj; u32x2 w; w.x = cvt_pk_bf16(S[j][0], S[j][1]); w.y = cvt_pk_bf16(S[j][2], S[j][3]);
                          *(u32x2*)(ST + (16 * j + fr) * 272 + (16 * wave + 4 * fq) * 2) = w; } } } }
            if (MODE == 2) {
            LBAR();
            f32x4 o[2][4];
#pragma unroll
            for (int jj = 0; jj < 2; ++jj)
#pragma unroll
                for (int tt = 0; tt < 4; ++tt) o[jj][tt] = (f32x4){0.f, 0.f, 0.f, 0.f};
#pragma unroll
            for (int ks = 0; ks < 4; ++ks) {
                bf16x8 av[2], bq[4];
#pragma unroll
                for (int jj = 0; jj < 2; ++jj) av[jj] = ldsfrag(ST + (16 * (2 * wave + jj) + fr) * 272 + ks * 64 + fq * 16);
#pragma unroll
                for (int tt = 0; tt < 4; ++tt) bq[tt] = ldsfrag(Qs + (16 * tt + fr) * 272 + ks * 64 + fq * 16);
#pragma unroll
                for (int jj = 0; jj < 2; ++jj)
#pragma unroll
                    for (int tt = 0; tt < 4; ++tt) o[jj][tt] = MFMA16(av[jj], bq[tt], o[jj][tt]);
            }
#pragma unroll
            for (int jj = 0; jj < 2; ++jj)
#pragma unroll
                for (int tt = 0; tt < 4; ++tt) { u32x2 w; w.x = cvt_pk_bf16(o[jj][tt][0], o[jj][tt][1]); w.y = cvt_pk_bf16(o[jj][tt][2], o[jj][tt][3]);
                    *(u32x2*)(OPRE + (size_t)(row0 + 16 * tt + fr) * DM + h * 256 + 16 * (2 * wave + jj) + 4 * fq) = w; }
            }
        }
        if (MODE == 1) {
#pragma unroll
            for (int j = 0; j < 16; ++j) *(f32x4*)(sl + (16 * j + fr) * 128 + 16 * wave + 4 * fq) = S[j];
            if (fr == 0) *(f32x4*)(DSEG + (size_t)u * 128 + 16 * wave + 4 * fq) = dprod;
        }
    }
#undef GLA_LOAD
}
__device__ __forceinline__ void gla_combine_phase(const Params& p, int bid, int G, int tid) {
    float* SLOC = (float*)(p.ws + WS_BIG + BIG_GLA_SLOC); const float* DSEG = (const float*)(p.ws + WS_BIG + BIG_GLA_DSEG);
    for (int idx = bid * 512 + tid; idx < 32 * 8192; idx += G * 512) { const int bh = idx >> 13, e = (idx & 8191) * 4, k0 = e & 127;
        f32x4 prev = (f32x4){0.f, 0.f, 0.f, 0.f};
#pragma unroll
        for (int seg = 0; seg < 8; ++seg) { const int u = bh * 8 + seg; f32x4* q = (f32x4*)(SLOC + (size_t)u * 32768 + e);
            f32x4 loc = (f32x4){0.f, 0.f, 0.f, 0.f}, d = (f32x4){0.f, 0.f, 0.f, 0.f};
            if (seg < 7) { loc = *q; d = *(const f32x4*)(DSEG + (size_t)u * 128 + k0); }
            *q = prev; prev = loc + d * prev; } }
}

__device__ __forceinline__ void gla3_phase(const Params& p, int gw, int NGW, int lane) {
    unsigned char* ws = p.ws;
    const bf16_t* P = (const bf16_t*)(ws + WS_BIG); bf16_t* OPRE = (bf16_t*)(ws + WS_BIG + BIG_GLA_OPRE);
    const float* nw = p.in[I_GLA_NW] + 16 * lane;
    float nwv[16];
#pragma unroll
    for (int i = 0; i < 16; ++i) nwv[i] = nw[i];
    for (int m = gw; m < NTOK; m += NGW) {
        u32x4* op = (u32x4*)(OPRE + (size_t)m * DM + 16 * lane); const u32x4* rp = (const u32x4*)(P + (size_t)m * 3072 + 2048 + 16 * lane);
        const u32x4 o0 = op[0], o1 = op[1], r0 = rp[0], r1 = rp[1];
        float ov[16], rv[16];
#pragma unroll
        for (int i = 0; i < 4; ++i) { ov[2 * i] = bflo(o0[i]); ov[2 * i + 1] = bfhi(o0[i]); ov[8 + 2 * i] = bflo(o1[i]); ov[8 + 2 * i + 1] = bfhi(o1[i]);
            rv[2 * i] = bflo(r0[i]); rv[2 * i + 1] = bfhi(r0[i]); rv[8 + 2 * i] = bflo(r1[i]); rv[8 + 2 * i + 1] = bfhi(r1[i]); }
        float ss = 0.f;
#pragma unroll
        for (int i = 0; i < 16; ++i) ss += ov[i] * ov[i];
        ss += __shfl_xor(ss, 1); ss += __shfl_xor(ss, 2); ss += __shfl_xor(ss, 4); ss += __shfl_xor(ss, 8);
        const float rstd = rsqrtf(ss * (1.0f / 256.0f) + 1e-6f);
        float res[16];
#pragma unroll
        for (int i = 0; i < 16; ++i) res[i] = ov[i] * rstd * nwv[i] * fast_silu(rv[i]);
        u32x4 w0, w1;
#pragma unroll
        for (int i = 0; i < 4; ++i) { w0[i] = cvt_pk_bf16(res[2 * i], res[2 * i + 1]); w1[i] = cvt_pk_bf16(res[8 + 2 * i], res[8 + 2 * i + 1]); }
        op[0] = w0; op[1] = w1;
    }
}

__device__ __forceinline__ void pool_dlt_phase(const Params& p, unsigned char* lds, int bid, int G, int tid) {
    unsigned char* ws = p.ws;
    const bf16_t* X = (const bf16_t*)(ws + WS_XB); const float* rssp = (const float*)(ws + WS_RSSP); bf16_t* DLT = (bf16_t*)(ws + WS_BIG);
    float* rs_s = (float*)lds;
    const int c = 2 * tid; const int win = 2 << (c >> 8);
    const float w0 = p.in[I_MIXNW][1024 + c], w1 = p.in[I_MIXNW][1024 + c + 1];
    for (int u = bid; u < 512; u += G) {
        const int b = u >> 6, t0 = (u & 63) * 64;
        __syncthreads();
        if (tid < 79) { const int j = t0 - 15 + tid; rs_s[tid] = j >= 0 ? row_rstd(rssp, b * SEQL + j) : 0.f; }
        __syncthreads();
        float s0 = 0.f, s1 = 0.f;
        for (int j = t0 - win + 1; j < t0; ++j) if (j >= 0) { const unsigned xv = *(const unsigned*)(X + (size_t)(b * SEQL + j) * DM + c); const float r = rs_s[j - t0 + 15]; s0 += bflo(xv) * r * w0; s1 += bfhi(xv) * r * w1; }
#pragma unroll 8
        for (int t = t0; t < t0 + 64; ++t) {
            const unsigned xv = *(const unsigned*)(X + (size_t)(b * SEQL + t) * DM + c); const float r = rs_s[t - t0 + 15];
            const float h0 = bflo(xv) * r * w0, h1 = bfhi(xv) * r * w1; s0 += h0; s1 += h1;
            const float inv = 1.0f / (float)min(t + 1, win);
            *(unsigned*)(DLT + (size_t)(b * SEQL + t) * DM + c) = cvt_pk_bf16(s0 * inv - h0, s1 * inv - h1);
            const int jo = t - win + 1;
            if (jo >= 0) { const unsigned xo = *(const unsigned*)(X + (size_t)(b * SEQL + jo) * DM + c); const float ro = rs_s[jo - t0 + 15]; s0 -= bflo(xo) * ro * w0; s1 -= bfhi(xo) * ro * w1; }
        }
    }
}

__device__ __forceinline__ float softplusf(float x) { return fmaxf(x, 0.f) + log1pf(expf(-fabsf(x))); }
constexpr size_t XBR_ACS = 0, XBR_HALO = 8 * MiB;
__device__ __forceinline__ void ssd_dt_fix_phase(const Params& p, unsigned char* lds, int bid, int G, int tid) {
    bf16_t* P = (bf16_t*)(p.ws + WS_BIG); float* DT = (float*)(p.ws + WS_BIG + BIG_SSD_DT); float* ACS = (float*)((unsigned char*)p.out + XBR_ACS);
    const float* side = (const float*)((unsigned char*)p.out + XBR_HALO);
    const float* cw = p.in[I_SSD_CW]; const float* cb = p.in[I_SSD_CB];
    float* tot_s = (float*)lds;
    for (int u = bid; u < 512; u += G) { const int b = u >> 6, c = u & 63; const int row0 = b * SEQL + c * 64;
        const int h = tid & 31, sg = tid >> 5; const float dtb = p.in[I_SSD_DTB][h], aneg = -expf(p.in[I_SSD_ALOG][h]);
        float dtv[4], ac[4]; float run = 0.f;
#pragma unroll
        for (int i = 0; i < 4; ++i) { dtv[i] = softplusf(DT[(size_t)(row0 + 4 * sg + i) * 32 + h] + dtb); run += dtv[i] * aneg; ac[i] = run; }
        __syncthreads(); tot_s[sg * 32 + h] = run; __syncthreads();
        float off = 0.f;
        for (int g2 = 0; g2 < sg; ++g2) off += tot_s[g2 * 32 + h];
#pragma unroll
        for (int i = 0; i < 4; ++i) { DT[(size_t)(row0 + 4 * sg + i) * 32 + h] = dtv[i]; ACS[(size_t)(row0 + 4 * sg + i) * 32 + h] = off + ac[i]; }
    }
    for (int idx = bid * 512 + tid; idx < 128 * 3 * 768; idx += G * 512) {
        const int q = idx % 768, r = idx / 768, tau = r % 3, pm = r / 3;
        if ((pm & 15) == 0) continue;
        const int xc = q * 4;
        const float* cur = side + (size_t)pm * 6 * 3072 + xc; const float* prv = side + (size_t)(pm - 1) * 6 * 3072 + xc;
        const f32x4 u0 = *(const f32x4*)(cur + tau * 3072);
        const f32x4 u1 = tau >= 1 ? *(const f32x4*)(cur + (tau - 1) * 3072) : *(const f32x4*)(prv + 5 * 3072);
        const f32x4 u2 = tau >= 2 ? *(const f32x4*)(cur + (tau - 2) * 3072) : *(const f32x4*)(prv + (4 + tau) * 3072);
        const f32x4 u3 = *(const f32x4*)(prv + (3 + tau) * 3072);
        const f32x4 o = *(const f32x4*)(cb + xc) + *(const f32x4*)(cw + 3 * 3072 + xc) * u0 + *(const f32x4*)(cw + 2 * 3072 + xc) * u1 + *(const f32x4*)(cw + 3072 + xc) * u2 + *(const f32x4*)(cw + xc) * u3;
        u32x2 w; w.x = cvt_pk_bf16(fast_silu(o[0]), fast_silu(o[1])); w.y = cvt_pk_bf16(fast_silu(o[2]), fast_silu(o[3]));
        *(u32x2*)(P + (size_t)(pm * 256 + tau) * 5120 + 2048 + xc) = w;
    }
}
__device__ __forceinline__ void ssd_scan_phase(const Params& p, unsigned char* lds, int bid, int G, int tid, int wave, int lane, int dry) {
    unsigned char* ws = p.ws;
    bf16_t* P = (bf16_t*)(ws + WS_BIG); const float* DT = (const float*)(ws + WS_BIG + BIG_SSD_DT); const float* ACS = (const float*)((unsigned char*)p.out + XBR_ACS);
    unsigned char* Cm = lds;
    unsigned char* Bm = lds + 17408;
    unsigned char* BdT = lds + 34816;
    unsigned char* xdtT = lds + 53248;
    unsigned char* xT = lds + 62464;
    unsigned char* Mt = lds + 71680;
    unsigned char* stB = lds + 80896;
    float* acs_s = (float*)(lds + 115712);
    const int fr = lane & 15, fq = lane >> 4;
    for (int u = bid; u < 256; u += G) {
        const int b = u >> 5, h = u & 31, g = h >> 3;
        const float dsk = p.in[I_SSD_D][h];
        f32x4 st[4];
#pragma unroll
        for (int i = 0; i < 4; ++i) st[i] = (f32x4){0.f, 0.f, 0.f, 0.f};
        LBAR();
        for (int e = tid; e < 64 * 272 / 4; e += 512) ((unsigned*)stB)[e] = 0u;
        const int sx = tid >> 3, partx = tid & 7;
        u32x4 pxA, pbA[2], pcA[2], pxB, pbB[2], pcB[2]; float pdtA, pacsbA[2], pacs_endA, pacs_tA = 0.f, pdtB, pacsbB[2], pacs_endB, pacs_tB = 0.f;
#define SSD_LOAD(S_, cc) do { const int r0_ = b * SEQL + (cc) * 64; \
            px##S_ = *(const u32x4*)(P + (size_t)(r0_ + sx) * 5120 + 2048 + h * 64 + partx * 8); pdt##S_ = DT[(size_t)(r0_ + sx) * 32 + h]; \
            _Pragma("unroll") for (int i_ = 0; i_ < 2; ++i_) { const int e_ = tid + 512 * i_; const int sb_ = e_ >> 4, pt_ = e_ & 15; \
                pb##S_[i_] = *(const u32x4*)(P + (size_t)(r0_ + sb_) * 5120 + 4096 + g * 128 + pt_ * 8); pc##S_[i_] = *(const u32x4*)(P + (size_t)(r0_ + sb_) * 5120 + 4608 + g * 128 + pt_ * 8); \
                pacsb##S_[i_] = ACS[(size_t)(r0_ + sb_) * 32 + h]; } \
            pacs_end##S_ = ACS[(size_t)(r0_ + 63) * 32 + h]; if (tid < 64) pacs_t##S_ = ACS[(size_t)(r0_ + tid) * 32 + h]; } while (0)
        SSD_LOAD(A, 0); SSD_LOAD(B, 1);
        for (int c0 = 0; c0 < 64; c0 += 2) {
          { const int c = c0;
            const int row0 = b * SEQL + c * 64;
            LBAR();
            const float acs_end = pacs_endA;
            {
#pragma unroll
                for (int j = 0; j < 4; ++j) { const unsigned w = pxA[j]; const float x0 = bflo(w), x1 = bfhi(w);
                    *(bf16_t*)(xT + swz144(partx * 8 + 2 * j, sx * 2)) = (bf16_t)(w & 0xffffu); *(bf16_t*)(xT + swz144(partx * 8 + 2 * j + 1, sx * 2)) = (bf16_t)(w >> 16);
                    const unsigned d = cvt_pk_bf16(x0 * pdtA, x1 * pdtA);
                    *(bf16_t*)(xdtT + swz144(partx * 8 + 2 * j, sx * 2)) = (bf16_t)(d & 0xffffu); *(bf16_t*)(xdtT + swz144(partx * 8 + 2 * j + 1, sx * 2)) = (bf16_t)(d >> 16); }
#pragma unroll
                for (int i = 0; i < 2; ++i) { const int e = tid + 512 * i; const int sb = e >> 4, pt = e & 15;
                    *(u32x4*)(Bm + sb * 272 + pt * 16) = pbA[i]; *(u32x4*)(Cm + sb * 272 + pt * 16) = pcA[i];
                    const float dec = __expf(acs_end - pacsbA[i]);
#pragma unroll
                    for (int j = 0; j < 4; ++j) { const unsigned w = pbA[i][j]; const unsigned d = cvt_pk_bf16(bflo(w) * dec, bfhi(w) * dec);
                        *(bf16_t*)(BdT + swz144(pt * 8 + 2 * j, sb * 2)) = (bf16_t)(d & 0xffffu); *(bf16_t*)(BdT + swz144(pt * 8 + 2 * j + 1, sb * 2)) = (bf16_t)(d >> 16); } }
                if (tid < 64) acs_s[tid] = pacs_tA;
            }
            if (c + 2 < 64) SSD_LOAD(A, c + 2);
            LBAR();
            bf16x8 c0[4], c1[4];
            { const int stl = wave >> 1; const int tt0 = (wave & 1) * 2;
              bf16x8 a[4];
#pragma unroll
              for (int ks = 0; ks < 4; ++ks) { a[ks] = ldsfrag(Bm + (16 * stl + fr) * 272 + ks * 64 + fq * 16); c0[ks] = ldsfrag(Cm + (16 * tt0 + fr) * 272 + ks * 64 + fq * 16); c1[ks] = ldsfrag(Cm + (16 * (tt0 + 1) + fr) * 272 + ks * 64 + fq * 16); }
              const f32x4 as4 = *(const f32x4*)(acs_s + 16 * stl + 4 * fq); const float at0 = acs_s[16 * tt0 + fr], at1 = acs_s[16 * tt0 + 16 + fr];
              f32x4 d0 = (f32x4){0.f, 0.f, 0.f, 0.f}, d1 = d0;
#pragma unroll
              for (int ks = 0; ks < 4; ++ks) { d0 = MFMA16(a[ks], c0[ks], d0); d1 = MFMA16(a[ks], c1[ks], d1); }
#pragma unroll
              for (int tj = 0; tj < 2; ++tj) { const int t = 16 * (tt0 + tj) + fr; const float at = tj ? at1 : at0; const f32x4 d = tj ? d1 : d0; float mv[4];
#pragma unroll
                  for (int i = 0; i < 4; ++i) { const int sidx = 16 * stl + 4 * fq + i; const float e = __expf(fminf(at - as4[i], 0.f)); mv[i] = (sidx <= t) ? d[i] * e : 0.f; }
                  u32x2 w; w.x = cvt_pk_bf16(mv[0], mv[1]); w.y = cvt_pk_bf16(mv[2], mv[3]);
                  *(u32x2*)(Mt + t * 144 + (16 * stl + 4 * fq) * 2) = w; } }
            { const float ee = __expf(acs_end);
              const bf16x8 a0 = ldsfrag(BdT + swz144(16 * wave + fr, fq * 16)), a1 = ldsfrag(BdT + swz144(16 * wave + fr, 64 + fq * 16));
              bf16x8 xb0[4], xb1[4];
#pragma unroll
              for (int pt = 0; pt < 4; ++pt) { xb0[pt] = ldsfrag(xdtT + swz144(16 * pt + fr, fq * 16)); xb1[pt] = ldsfrag(xdtT + swz144(16 * pt + fr, 64 + fq * 16)); }
#pragma unroll
              for (int pt = 0; pt < 4; ++pt) st[pt] = st[pt] * ee;
#pragma unroll
              for (int pt = 0; pt < 4; ++pt) st[pt] = MFMA16(a0, xb0[pt], st[pt]);
#pragma unroll
              for (int pt = 0; pt < 4; ++pt) st[pt] = MFMA16(a1, xb1[pt], st[pt]);
#pragma unroll
              for (int pt = 0; pt < 4; ++pt) { u32x2 w; w.x = cvt_pk_bf16(st[pt][0], st[pt][1]); w.y = cvt_pk_bf16(st[pt][2], st[pt][3]);
                  *(u32x2*)(stB + ((c + 1) & 1) * 17408 + (16 * pt + fr) * 272 + (16 * wave + 4 * fq) * 2) = w; } }
            LBAR();
            { const int pt = wave >> 1; const int tt0 = (wave & 1) * 2;
              bf16x8 ax[2], as_[4], m0[2], m1[2];
#pragma unroll
              for (int ks = 0; ks < 2; ++ks) { ax[ks] = ldsfrag(xdtT + swz144(16 * pt + fr, ks * 64 + fq * 16)); m0[ks] = ldsfrag(Mt + (16 * tt0 + fr) * 144 + ks * 64 + fq * 16); m1[ks] = ldsfrag(Mt + (16 * tt0 + 16 + fr) * 144 + ks * 64 + fq * 16); }
#pragma unroll
              for (int ks = 0; ks < 4; ++ks) as_[ks] = ldsfrag(stB + (c & 1) * 17408 + (16 * pt + fr) * 272 + ks * 64 + fq * 16);
              const float ea0 = __expf(acs_s[16 * tt0 + fr]), ea1 = __expf(acs_s[16 * tt0 + 16 + fr]);
              float xs0[4], xs1[4];
#pragma unroll
              for (int i = 0; i < 4; ++i) { const int pp = 16 * pt + 4 * fq + i; xs0[i] = bf1(*(const bf16_t*)(xT + swz144(pp, (16 * tt0 + fr) * 2))); xs1[i] = bf1(*(const bf16_t*)(xT + swz144(pp, (16 * tt0 + 16 + fr) * 2))); }
              f32x4 yi0 = (f32x4){0.f, 0.f, 0.f, 0.f}, yi1 = yi0, ys0 = yi0, ys1 = yi0;
#pragma unroll
              for (int ks = 0; ks < 2; ++ks) { yi0 = MFMA16(ax[ks], m0[ks], yi0); yi1 = MFMA16(ax[ks], m1[ks], yi1); }
#pragma unroll
              for (int ks = 0; ks < 4; ++ks) { ys0 = MFMA16(as_[ks], c0[ks], ys0); ys1 = MFMA16(as_[ks], c1[ks], ys1); }
              u32x2 w0, w1;
              w0.x = cvt_pk_bf16(yi0[0] + ea0 * ys0[0] + dsk * xs0[0], yi0[1] + ea0 * ys0[1] + dsk * xs0[1]); w0.y = cvt_pk_bf16(yi0[2] + ea0 * ys0[2] + dsk * xs0[2], yi0[3] + ea0 * ys0[3] + dsk * xs0[3]);
              w1.x = cvt_pk_bf16(yi1[0] + ea1 * ys1[0] + dsk * xs1[0], yi1[1] + ea1 * ys1[1] + dsk * xs1[1]); w1.y = cvt_pk_bf16(yi1[2] + ea1 * ys1[2] + dsk * xs1[2], yi1[3] + ea1 * ys1[3] + dsk * xs1[3]);
              if (!dry) { *(u32x2*)(P + (size_t)(row0 + 16 * tt0 + fr) * 5120 + 2048 + h * 64 + 16 * pt + 4 * fq) = w0; *(u32x2*)(P + (size_t)(row0 + 16 * tt0 + 16 + fr) * 5120 + 2048 + h * 64 + 16 * pt + 4 * fq) = w1; } }
          }
          { const int c = c0 + 1;
            const int row0 = b * SEQL + c * 64;
            LBAR();
            const float acs_end = pacs_endB;
            {
#pragma unroll
                for (int j = 0; j < 4; ++j) { const unsigned w = pxB[j]; const float x0 = bflo(w), x1 = bfhi(w);
                    *(bf16_t*)(xT + swz144(partx * 8 + 2 * j, sx * 2)) = (bf16_t)(w & 0xffffu); *(bf16_t*)(xT + swz144(partx * 8 + 2 * j + 1, sx * 2)) = (bf16_t)(w >> 16);
                    const unsigned d = cvt_pk_bf16(x0 * pdtB, x1 * pdtB);
                    *(bf16_t*)(xdtT + swz144(partx * 8 + 2 * j, sx * 2)) = (bf16_t)(d & 0xffffu); *(bf16_t*)(xdtT + swz144(partx * 8 + 2 * j + 1, sx * 2)) = (bf16_t)(d >> 16); }
#pragma unroll
                for (int i = 0; i < 2; ++i) { const int e = tid + 512 * i; const int sb = e >> 4, pt = e & 15;
                    *(u32x4*)(Bm + sb * 272 + pt * 16) = pbB[i]; *(u32x4*)(Cm + sb * 272 + pt * 16) = pcB[i];
                    const float dec = __expf(acs_end - pacsbB[i]);
#pragma unroll
                    for (int j = 0; j < 4; ++j) { const unsigned w = pbB[i][j]; const unsigned d = cvt_pk_bf16(bflo(w) * dec, bfhi(w) * dec);
                        *(bf16_t*)(BdT + swz144(pt * 8 + 2 * j, sb * 2)) = (bf16_t)(d & 0xffffu); *(bf16_t*)(BdT + swz144(pt * 8 + 2 * j + 1, sb * 2)) = (bf16_t)(d >> 16); } }
                if (tid < 64) acs_s[tid] = pacs_tB;
            }
            if (c + 2 < 64) SSD_LOAD(B, c + 2);
            LBAR();
            bf16x8 c0[4], c1[4];
            { const int stl = wave >> 1; const int tt0 = (wave & 1) * 2;
              bf16x8 a[4];
#pragma unroll
              for (int ks = 0; ks < 4; ++ks) { a[ks] = ldsfrag(Bm + (16 * stl + fr) * 272 + ks * 64 + fq * 16); c0[ks] = ldsfrag(Cm + (16 * tt0 + fr) * 272 + ks * 64 + fq * 16); c1[ks] = ldsfrag(Cm + (16 * (tt0 + 1) + fr) * 272 + ks * 64 + fq * 16); }
              const f32x4 as4 = *(const f32x4*)(acs_s + 16 * stl + 4 * fq); const float at0 = acs_s[16 * tt0 + fr], at1 = acs_s[16 * tt0 + 16 + fr];
              f32x4 d0 = (f32x4){0.f, 0.f, 0.f, 0.f}, d1 = d0;
#pragma unroll
              for (int ks = 0; ks < 4; ++ks) { d0 = MFMA16(a[ks], c0[ks], d0); d1 = MFMA16(a[ks], c1[ks], d1); }
#pragma unroll
              for (int tj = 0; tj < 2; ++tj) { const int t = 16 * (tt0 + tj) + fr; const float at = tj ? at1 : at0; const f32x4 d = tj ? d1 : d0; float mv[4];
#pragma unroll
                  for (int i = 0; i < 4; ++i) { const int sidx = 16 * stl + 4 * fq + i; const float e = __expf(fminf(at - as4[i], 0.f)); mv[i] = (sidx <= t) ? d[i] * e : 0.f; }
                  u32x2 w; w.x = cvt_pk_bf16(mv[0], mv[1]); w.y = cvt_pk_bf16(mv[2], mv[3]);
                  *(u32x2*)(Mt + t * 144 + (16 * stl + 4 * fq) * 2) = w; } }
            { const float ee = __expf(acs_end);
              const bf16x8 a0 = ldsfrag(BdT + swz144(16 * wave + fr, fq * 16)), a1 = ldsfrag(BdT + swz144(16 * wave + fr, 64 + fq * 16));
              bf16x8 xb0[4], xb1[4];
#pragma unroll
              for (int pt = 0; pt < 4; ++pt) { xb0[pt] = ldsfrag(xdtT + swz144(16 * pt + fr, fq * 16)); xb1[pt] = ldsfrag(xdtT + swz144(16 * pt + fr, 64 + fq * 16)); }
#pragma unroll
              for (int pt = 0; pt < 4; ++pt) st[pt] = st[pt] * ee;
#pragma unroll
              for (int pt = 0; pt < 4; ++pt) st[pt] = MFMA16(a0, xb0[pt], st[pt]);
#pragma unroll
              for (int pt = 0; pt < 4; ++pt) st[pt] = MFMA16(a1, xb1[pt], st[pt]);
#pragma unroll
              for (int pt = 0; pt < 4; ++pt) { u32x2 w; w.x = cvt_pk_bf16(st[pt][0], st[pt][1]); w.y = cvt_pk_bf16(st[pt][2], st[pt][3]);
                  *(u32x2*)(stB + ((c + 1) & 1) * 17408 + (16 * pt + fr) * 272 + (16 * wave + 4 * fq) * 2) = w; } }
            LBAR();
            { const int pt = wave >> 1; const int tt0 = (wave & 1) * 2;
              bf16x8 ax[2], as_[4], m0[2], m1[2];
#pragma unroll
              for (int ks = 0; ks < 2; ++ks) { ax[ks] = ldsfrag(xdtT + swz144(16 * pt + fr, ks * 64 + fq * 16)); m0[ks] = ldsfrag(Mt + (16 * tt0 + fr) * 144 + ks * 64 + fq * 16); m1[ks] = ldsfrag(Mt + (16 * tt0 + 16 + fr) * 144 + ks * 64 + fq * 16); }
#pragma unroll
              for (int ks = 0; ks < 4; ++ks) as_[ks] = ldsfrag(stB + (c & 1) * 17408 + (16 * pt + fr) * 272 + ks * 64 + fq * 16);
              const float ea0 = __expf(acs_s[16 * tt0 + fr]), ea1 = __expf(acs_s[16 * tt0 + 16 + fr]);
              float xs0[4], xs1[4];
#pragma unroll
              for (int i = 0; i < 4; ++i) { const int pp = 16 * pt + 4 * fq + i; xs0[i] = bf1(*(const bf16_t*)(xT + swz144(pp, (16 * tt0 + fr) * 2))); xs1[i] = bf1(*(const bf16_t*)(xT + swz144(pp, (16 * tt0 + 16 + fr) * 2))); }
              f32x4 yi0 = (f32x4){0.f, 0.f, 0.f, 0.f}, yi1 = yi0, ys0 = yi0, ys1 = yi0;
#pragma unroll
              for (int ks = 0; ks < 2; ++ks) { yi0 = MFMA16(ax[ks], m0[ks], yi0); yi1 = MFMA16(ax[ks], m1[ks], yi1); }
#pragma unroll
              for (int ks = 0; ks < 4; ++ks) { ys0 = MFMA16(as_[ks], c0[ks], ys0); ys1 = MFMA16(as_[ks], c1[ks], ys1); }
              u32x2 w0, w1;
              w0.x = cvt_pk_bf16(yi0[0] + ea0 * ys0[0] + dsk * xs0[0], yi0[1] + ea0 * ys0[1] + dsk * xs0[1]); w0.y = cvt_pk_bf16(yi0[2] + ea0 * ys0[2] + dsk * xs0[2], yi0[3] + ea0 * ys0[3] + dsk * xs0[3]);
              w1.x = cvt_pk_bf16(yi1[0] + ea1 * ys1[0] + dsk * xs1[0], yi1[1] + ea1 * ys1[1] + dsk * xs1[1]); w1.y = cvt_pk_bf16(yi1[2] + ea1 * ys1[2] + dsk * xs1[2], yi1[3] + ea1 * ys1[3] + dsk * xs1[3]);
              if (!dry) { *(u32x2*)(P + (size_t)(row0 + 16 * tt0 + fr) * 5120 + 2048 + h * 64 + 16 * pt + 4 * fq) = w0; *(u32x2*)(P + (size_t)(row0 + 16 * tt0 + 16 + fr) * 5120 + 2048 + h * 64 + 16 * pt + 4 * fq) = w1; } }
          }
        }
    }
}

__device__ __forceinline__ void ssd3_phase(const Params& p, int gw, int NGW, int lane) {
    bf16_t* P = (bf16_t*)(p.ws + WS_BIG);
    for (int m = gw; m < NTOK; m += NGW) {
        u32x4* yp = (u32x4*)(P + (size_t)m * 5120 + 2048 + 32 * lane); const u32x4* zp = (const u32x4*)(P + (size_t)m * 5120 + 32 * lane);
        float v[32]; float ss = 0.f;
#pragma unroll
        for (int q = 0; q < 4; ++q) { const u32x4 y = yp[q], z = zp[q];
#pragma unroll
            for (int i = 0; i < 4; ++i) { const float a = bflo(y[i]) * fast_silu(bflo(z[i])), c = bfhi(y[i]) * fast_silu(bfhi(z[i])); v[8 * q + 2 * i] = a; v[8 * q + 2 * i + 1] = c; ss += a * a + c * c; } }
        ss += __shfl_xor(ss, 1); ss += __shfl_xor(ss, 2); ss += __shfl_xor(ss, 4); ss += __shfl_xor(ss, 8);
        const float rstd = rsqrtf(ss * (1.0f / 512.0f) + 1e-6f);
#pragma unroll
        for (int q = 0; q < 4; ++q) { u32x4 w;
#pragma unroll
            for (int i = 0; i < 4; ++i) w[i] = cvt_pk_bf16(v[8 * q + 2 * i] * rstd, v[8 * q + 2 * i + 1] * rstd);
            yp[q] = w; }
    }
}

__device__ __forceinline__ void sb_attn_phase(const Params& p, unsigned char* lds, int bid, int G, int tid, int wave, int lane) {
    unsigned char* ws = p.ws;
    const bf16_t* P = (const bf16_t*)(ws + WS_BIG); bf16_t* AO = (bf16_t*)(ws + WS_BIG + BIG_SB_AO);
    unsigned char* Ks = lds;
    unsigned char* VTs = lds + 9216;
    int* flags = (int*)(lds + 18432);
    const int fr = lane & 15, fq = lane >> 4;
    bf16x8 U[4][2], ones;
#pragma unroll
    for (int jj = 0; jj < 8; ++jj) ones[jj] = (short)0x3F80;
#pragma unroll
    for (int io = 0; io < 4; ++io)
#pragma unroll
        for (int ks = 0; ks < 2; ++ks)
#pragma unroll
            for (int jj = 0; jj < 8; ++jj) { const int kj = 32 * ks + (jj < 4 ? 4 * fq + jj : 16 + 4 * fq + (jj - 4)); U[io][ks][jj] = (kj > 16 * io + fr) ? (short)0x3F80 : (short)0; }
    const int ss_ = tid >> 3, part_ = tid & 7; u32x4 pkkA, pvvA, pkkB, pvvB;
#define SB_LOAD(S_, b_, h_, kt_) do { const size_t krow_ = (size_t)((b_) * SEQL + 64 * (kt_) + ss_) * 3072; pkk##S_ = *(const u32x4*)(P + krow_ + 1024 + (h_) * 64 + part_ * 8); pvv##S_ = *(const u32x4*)(P + krow_ + 2048 + (h_) * 64 + part_ * 8); } while (0)
    if (bid < 4096) { const int qbn = 31 - (bid >> 7), bhn = bid & 127; SB_LOAD(A, bhn >> 4, bhn & 15, qbn * 2 + 1); SB_LOAD(B, bhn >> 4, bhn & 15, qbn * 2); }
    for (int u = bid; u < 4096; u += G) {
        const int qb = 31 - (u >> 7), bh = u & 127, b = bh >> 4, h = bh & 15;
        const int q0 = qb * 128; const int tq = q0 + 16 * wave + fr;
        const size_t qrow = (size_t)(b * SEQL + tq);
        const bf16x8 bq0 = *(const bf16x8*)(P + qrow * 3072 + h * 64 + fq * 8), bq1 = *(const bf16x8*)(P + qrow * 3072 + h * 64 + 32 + fq * 8);
        f32x4 O[4];
#pragma unroll
        for (int i = 0; i < 4; ++i) O[i] = (f32x4){0.f, 0.f, 0.f, 0.f};
        float carry = 0.f; bool wdone_prev = false;
        const int kt_hi = q0 / 64 + 1;
        for (int kt0 = kt_hi; kt0 >= 0; kt0 -= 2) {
          { const int kt = kt0;
            LBAR();
            if (kt != kt_hi) { int fs = 0;
#pragma unroll
                for (int i = 0; i < 8; ++i) fs += flags[i];
                if (fs == 8) break; }
            { *(u32x4*)(Ks + ss_ * 144 + part_ * 16) = pkkA;
#pragma unroll
              for (int i = 0; i < 4; ++i) { *(bf16_t*)(VTs + swz144(part_ * 8 + 2 * i, ss_ * 2)) = (bf16_t)(pvvA[i] & 0xffffu); *(bf16_t*)(VTs + swz144(part_ * 8 + 2 * i + 1, ss_ * 2)) = (bf16_t)(pvvA[i] >> 16); } }
            if (kt > 1) SB_LOAD(A, b, h, kt - 2);
            LBAR();
            const bool wskip = wdone_prev || (64 * kt >= q0 + 16 * wave + 15);
            if (!wskip) {
            const bool need_mask = (64 * kt + 63 >= q0 + 16 * wave);
            float nl[4][4], lz[4][4];
            bf16x8 kf0[4], kf1[4];
#pragma unroll
            for (int io = 0; io < 4; ++io) { kf0[io] = ldsfrag(Ks + (16 * io + fr) * 144 + fq * 16); kf1[io] = ldsfrag(Ks + (16 * io + fr) * 144 + 64 + fq * 16); }
            f32x4 zt[4];
#pragma unroll
            for (int io = 0; io < 4; ++io) zt[io] = MFMA16(kf0[io], bq0, ((f32x4){0.f, 0.f, 0.f, 0.f}));
#pragma unroll
            for (int io = 0; io < 4; ++io) zt[io] = MFMA16(kf1[io], bq1, zt[io]);
#pragma unroll
            for (int io = 0; io < 4; ++io) { const f32x4 z = zt[io];
#pragma unroll
                for (int i = 0; i < 4; ++i) { const float zz = z[i];
                    const float sp = fmaxf(zz, 0.f) + __builtin_amdgcn_logf(1.f + __builtin_amdgcn_exp2f(-fabsf(zz)));
                    nl[io][i] = sp; lz[io][i] = zz - sp; } }
            if (need_mask) {
#pragma unroll
                for (int io = 0; io < 4; ++io)
#pragma unroll
                    for (int i = 0; i < 4; ++i) { const int key = 64 * kt + 16 * io + 4 * fq + i; if (key >= tq) { nl[io][i] = 0.f; lz[io][i] = -1e30f; } } }
            bf16x8 bh_[2];
#pragma unroll
            for (int ks = 0; ks < 2; ++ks) { u32x4 w; w.x = cvt_pk_bf16(nl[2 * ks][0], nl[2 * ks][1]); w.y = cvt_pk_bf16(nl[2 * ks][2], nl[2 * ks][3]); w.z = cvt_pk_bf16(nl[2 * ks + 1][0], nl[2 * ks + 1][1]); w.w = cvt_pk_bf16(nl[2 * ks + 1][2], nl[2 * ks + 1][3]); bh_[ks] = __builtin_bit_cast(bf16x8, w); }
            f32x4 tot = (f32x4){0.f, 0.f, 0.f, 0.f};
#pragma unroll
            for (int ks = 0; ks < 2; ++ks) tot = MFMA16(ones, bh_[ks], tot);
            float att[4][4];
#pragma unroll
            for (int io = 0; io < 4; ++io) { f32x4 sv = (f32x4){0.f, 0.f, 0.f, 0.f};
#pragma unroll
                for (int ks = 0; ks < 2; ++ks) sv = MFMA16(U[io][ks], bh_[ks], sv);
#pragma unroll
                for (int i = 0; i < 4; ++i) att[io][i] = __builtin_amdgcn_exp2f((lz[io][i] + carry) - sv[i]); }
            carry -= tot[0];
            bf16x8 pa[2];
#pragma unroll
            for (int ks = 0; ks < 2; ++ks) { u32x4 w; w.x = cvt_pk_bf16(att[2 * ks][0], att[2 * ks][1]); w.y = cvt_pk_bf16(att[2 * ks][2], att[2 * ks][3]); w.z = cvt_pk_bf16(att[2 * ks + 1][0], att[2 * ks + 1][1]); w.w = cvt_pk_bf16(att[2 * ks + 1][2], att[2 * ks + 1][3]); pa[ks] = __builtin_bit_cast(bf16x8, w); }
#pragma unroll
            for (int ks = 0; ks < 2; ++ks) { bf16x8 vf[4];
#pragma unroll
                for (int dt = 0; dt < 4; ++dt) { const u32x2 lo = *(const u32x2*)(VTs + swz144(16 * dt + fr, (32 * ks + 4 * fq) * 2)), hi = *(const u32x2*)(VTs + swz144(16 * dt + fr, (32 * ks + 16 + 4 * fq) * 2)); const u32x4 w = (u32x4){lo.x, lo.y, hi.x, hi.y}; vf[dt] = __builtin_bit_cast(bf16x8, w); }
#pragma unroll
                for (int dt = 0; dt < 4; ++dt) O[dt] = MFMA16(vf[dt], pa[ks], O[dt]); }
            }
            const bool wdone = (__builtin_amdgcn_ballot_w64(carry >= -152.0f) == 0ull);
            wdone_prev = wdone;
            if (lane == 0) flags[wave] = wdone ? 1 : 0;
          }
          if (kt0 == 0) break;
          { const int kt = kt0 - 1;
            LBAR();
            if (kt != kt_hi) { int fs = 0;
#pragma unroll
                for (int i = 0; i < 8; ++i) fs += flags[i];
                if (fs == 8) break; }
            { *(u32x4*)(Ks + ss_ * 144 + part_ * 16) = pkkB;
#pragma unroll
              for (int i = 0; i < 4; ++i) { *(bf16_t*)(VTs + swz144(part_ * 8 + 2 * i, ss_ * 2)) = (bf16_t)(pvvB[i] & 0xffffu); *(bf16_t*)(VTs + swz144(part_ * 8 + 2 * i + 1, ss_ * 2)) = (bf16_t)(pvvB[i] >> 16); } }
            if (kt > 1) SB_LOAD(B, b, h, kt - 2);
            LBAR();
            const bool wskip = wdone_prev || (64 * kt >= q0 + 16 * wave + 15);
            if (!wskip) {
            const bool need_mask = (64 * kt + 63 >= q0 + 16 * wave);
            float nl[4][4], lz[4][4];
            bf16x8 kf0[4], kf1[4];
#pragma unroll
            for (int io = 0; io < 4; ++io) { kf0[io] = ldsfrag(Ks + (16 * io + fr) * 144 + fq * 16); kf1[io] = ldsfrag(Ks + (16 * io + fr) * 144 + 64 + fq * 16); }
            f32x4 zt[4];
#pragma unroll
            for (int io = 0; io < 4; ++io) zt[io] = MFMA16(kf0[io], bq0, ((f32x4){0.f, 0.f, 0.f, 0.f}));
#pragma unroll
            for (int io = 0; io < 4; ++io) zt[io] = MFMA16(kf1[io], bq1, zt[io]);
#pragma unroll
            for (int io = 0; io < 4; ++io) { const f32x4 z = zt[io];
#pragma unroll
                for (int i = 0; i < 4; ++i) { const float zz = z[i];
                    const float sp = fmaxf(zz, 0.f) + __builtin_amdgcn_logf(1.f + __builtin_amdgcn_exp2f(-fabsf(zz)));
                    nl[io][i] = sp; lz[io][i] = zz - sp; } }
            if (need_mask) {
#pragma unroll
                for (int io = 0; io < 4; ++io)
#pragma unroll
                    for (int i = 0; i < 4; ++i) { const int key = 64 * kt + 16 * io + 4 * fq + i; if (key >= tq) { nl[io][i] = 0.f; lz[io][i] = -1e30f; } } }
            bf16x8 bh_[2];
#pragma unroll
            for (int ks = 0; ks < 2; ++ks) { u32x4 w; w.x = cvt_pk_bf16(nl[2 * ks][0], nl[2 * ks][1]); w.y = cvt_pk_bf16(nl[2 * ks][2], nl[2 * ks][3]); w.z = cvt_pk_bf16(nl[2 * ks + 1][0], nl[2 * ks + 1][1]); w.w = cvt_pk_bf16(nl[2 * ks + 1][2], nl[2 * ks + 1][3]); bh_[ks] = __builtin_bit_cast(bf16x8, w); }
            f32x4 tot = (f32x4){0.f, 0.f, 0.f, 0.f};
#pragma unroll
            for (int ks = 0; ks < 2; ++ks) tot = MFMA16(ones, bh_[ks], tot);
            float att[4][4];
#pragma unroll
            for (int io = 0; io < 4; ++io) { f32x4 sv = (f32x4){0.f, 0.f, 0.f, 0.f};
#pragma unroll
                for (int ks = 0; ks < 2; ++ks) sv = MFMA16(U[io][ks], bh_[ks], sv);
#pragma unroll
                for (int i = 0; i < 4; ++i) att[io][i] = __builtin_amdgcn_exp2f((lz[io][i] + carry) - sv[i]); }
            carry -= tot[0];
            bf16x8 pa[2];
#pragma unroll
            for (int ks = 0; ks < 2; ++ks) { u32x4 w; w.x = cvt_pk_bf16(att[2 * ks][0], att[2 * ks][1]); w.y = cvt_pk_bf16(att[2 * ks][2], att[2 * ks][3]); w.z = cvt_pk_bf16(att[2 * ks + 1][0], att[2 * ks + 1][1]); w.w = cvt_pk_bf16(att[2 * ks + 1][2], att[2 * ks + 1][3]); pa[ks] = __builtin_bit_cast(bf16x8, w); }
#pragma unroll
            for (int ks = 0; ks < 2; ++ks) { bf16x8 vf[4];
#pragma unroll
                for (int dt = 0; dt < 4; ++dt) { const u32x2 lo = *(const u32x2*)(VTs + swz144(16 * dt + fr, (32 * ks + 4 * fq) * 2)), hi = *(const u32x2*)(VTs + swz144(16 * dt + fr, (32 * ks + 16 + 4 * fq) * 2)); const u32x4 w = (u32x4){lo.x, lo.y, hi.x, hi.y}; vf[dt] = __builtin_bit_cast(bf16x8, w); }
#pragma unroll
                for (int dt = 0; dt < 4; ++dt) O[dt] = MFMA16(vf[dt], pa[ks], O[dt]); }
            }
            const bool wdone = (__builtin_amdgcn_ballot_w64(carry >= -152.0f) == 0ull);
            wdone_prev = wdone;
            if (lane == 0) flags[wave] = wdone ? 1 : 0;
          }
        }
        { const int un = u + G; if (un < 4096) { const int qbn = 31 - (un >> 7), bhn = un & 127; SB_LOAD(A, bhn >> 4, bhn & 15, qbn * 2 + 1); SB_LOAD(B, bhn >> 4, bhn & 15, qbn * 2); } }
#pragma unroll
        for (int dt = 0; dt < 4; ++dt) { u32x2 w; w.x = cvt_pk_bf16(O[dt][0], O[dt][1]); w.y = cvt_pk_bf16(O[dt][2], O[dt][3]);
            *(u32x2*)(AO + qrow * DM + h * 64 + 16 * dt + 4 * fq) = w; }
    }
}

__device__ __forceinline__ void ffn_fix_phase(const Params& p, int layer, int bid, int G, int tid) {
    const float* side = (const float*)(p.ws + WS_BIG + 176 * MiB); bf16_t* act = (bf16_t*)(p.ws + WS_BIG);
    const float* cw = p.in[I_FFN_CW] + (size_t)layer * 3 * 5632; const float* cb = p.in[I_FFN_CB] + (size_t)layer * 5632;
    for (int idx = bid * 512 + tid; idx < 128 * 2 * 704; idx += G * 512) {
        const int q = idx % 704, r = idx / 704, tau = r & 1, pm = r >> 1;
        if ((pm & 15) == 0) continue;
        const int c = q * 4, col = (c >> 7) * 256 + (c & 127);
        const float* s0 = side + ((size_t)pm * 4 + tau) * 5632 + col;
        const float* s1 = tau ? side + ((size_t)pm * 4) * 5632 + col : side + ((size_t)(pm - 1) * 4 + 3) * 5632 + col;
        const float* s2 = tau ? side + ((size_t)(pm - 1) * 4 + 3) * 5632 + col : side + ((size_t)(pm - 1) * 4 + 2) * 5632 + col;
        const f32x4 g = *(const f32x4*)(cb + c) + *(const f32x4*)(cw + 2 * 5632 + c) * *(const f32x4*)s0 + *(const f32x4*)(cw + 5632 + c) * *(const f32x4*)s1 + *(const f32x4*)(cw + c) * *(const f32x4*)s2;
        const f32x4 v = *(const f32x4*)(cb + FFD + c) + *(const f32x4*)(cw + 2 * 5632 + FFD + c) * *(const f32x4*)(s0 + 128) + *(const f32x4*)(cw + 5632 + FFD + c) * *(const f32x4*)(s1 + 128) + *(const f32x4*)(cw + FFD + c) * *(const f32x4*)(s2 + 128);
        u32x2 w; w.x = cvt_pk_bf16(fast_silu(g[0]) * v[0], fast_silu(g[1]) * v[1]); w.y = cvt_pk_bf16(fast_silu(g[2]) * v[2], fast_silu(g[3]) * v[3]);
        *(u32x2*)(act + ((size_t)(c >> 6) * NTOK + (pm * 256 + tau)) * 64 + (c & 63)) = w;
    }
}

__device__ __forceinline__ void final_phase(const Params& p, int gw, int NGW, int lane) {
    const float* rssp = (const float*)(p.ws + WS_RSSP); const bf16_t* XB = (const bf16_t*)(p.ws + WS_XB);
    f32x4 wv[4];
#pragma unroll
    for (int j = 0; j < 4; ++j) wv[j] = ((const f32x4*)p.in[I_FINNW] + lane)[64 * j];
    for (int m = gw; m < NTOK; m += NGW) { const float rs = row_rstd(rssp, m); f32x4* xr = (f32x4*)(p.out + (size_t)m * DM) + lane; const u32x2* xi = (const u32x2*)(XB + (size_t)m * DM) + lane;
#pragma unroll
        for (int j = 0; j < 4; ++j) { const u32x2 w = xi[64 * j]; f32x4 v = (f32x4){bflo(w.x), bfhi(w.x), bflo(w.y), bfhi(w.y)}; __builtin_nontemporal_store(v * rs * wv[j], xr + 64 * j); } }
}

#define XB_TMO      128
#define XB_XCNT(j)  (256  + 64 * (j))
#define XB_XSUB(j)  (1280 + 64 * (j))
#define XB_XGEN(j)  (2304 + 64 * (j))
#define XB_TOP      3328
#define XB_TOPGEN   3392
#define XCD_BAR_WORDS 3456
#define XB_SPIN_CAP (1u << 22)
__device__ __forceinline__ unsigned xb_ld(unsigned* p)              { return __hip_atomic_load(p, __ATOMIC_RELAXED, __HIP_MEMORY_SCOPE_AGENT); }
__device__ __forceinline__ unsigned xb_add(unsigned* p, unsigned v) { return __hip_atomic_fetch_add(p, v, __ATOMIC_RELAXED, __HIP_MEMORY_SCOPE_AGENT); }
__device__ __forceinline__ unsigned xb_xcc_id() { return (unsigned)__builtin_amdgcn_s_getreg((3 << 11) | 20) & 0xFu; }
#define XB_SPIN(cond, bar) do { unsigned _sp = 0; while (cond) { __builtin_amdgcn_s_sleep(1); \
    if ((++_sp & 255u) == 0u) { if (xb_ld(&(bar)[XB_TMO])) break; if (_sp > XB_SPIN_CAP) { atomicAdd(&(bar)[XB_TMO], 1u); break; } } } } while (0)
struct XcdBarrier { unsigned* bar; unsigned x; volatile LAS unsigned* st; };
__device__ __forceinline__ XcdBarrier xcd_barrier_post(unsigned* bar, volatile LAS unsigned* st) {
    XcdBarrier b; b.bar = bar; b.x = xb_xcc_id(); b.st = st;
    if (threadIdx.x == 0) (void)xb_add(&bar[XB_XCNT(b.x)], 1u);
    return b;
}
__device__ __forceinline__ void xcd_barrier_complete(unsigned* bar, unsigned x, unsigned& nloc, unsigned& nx) {
    const unsigned G = gridDim.x * gridDim.y * gridDim.z;
    unsigned sum, cnt, mine, sp = 0u;
    for (;;) {
        sum = 0u; cnt = 0u; mine = 0u;
#pragma unroll 1
        for (unsigned j = 0; j < 16; ++j) { const unsigned c = xb_ld(&bar[XB_XCNT(j)]); sum += c; cnt += (c > 0u) ? 1u : 0u; mine = (j == x) ? c : mine; }
        if (sum == G) break;
        __builtin_amdgcn_s_sleep(1);
        if ((++sp & 255u) == 0u) { if (xb_ld(&bar[XB_TMO])) break; if (sp > XB_SPIN_CAP) { atomicAdd(&bar[XB_TMO], 1u); break; } }
    }
    nloc = mine > 0u ? mine : 1u; nx = cnt > 0u ? cnt : 1u;
}
__device__ __forceinline__ void xcd_barrier(const XcdBarrier& b) {
    asm volatile("s_waitcnt vmcnt(0)" ::: "memory");
    __syncthreads();
    if (threadIdx.x == 0) {
        unsigned* bar = b.bar; asm volatile("" : "+s"(bar));
        __builtin_amdgcn_s_waitcnt(0);
        unsigned nloc = b.st[0], nx = b.st[1];
        if (nloc == 0u) { xcd_barrier_complete(bar, b.x, nloc, nx); b.st[0] = nloc; b.st[1] = nx; }
        const unsigned old = xb_add(&bar[XB_XSUB(b.x)], 1u);
        const unsigned gen = old / nloc;
        if (old + 1u == (gen + 1u) * nloc) {
            __builtin_amdgcn_fence(__ATOMIC_RELEASE, "agent");
            asm volatile("s_waitcnt vmcnt(0)" ::: "memory");
            const unsigned og = xb_add(&bar[XB_TOP], 1u);
            const unsigned tg = og / nx;
            if (og + 1u == (tg + 1u) * nx) xb_add(&bar[XB_TOPGEN], 1u);
            else XB_SPIN(xb_ld(&bar[XB_TOPGEN]) == tg, bar);
            __builtin_amdgcn_fence(__ATOMIC_ACQUIRE, "agent");
            xb_add(&bar[XB_XGEN(b.x)], 1u);
            asm volatile("s_waitcnt vmcnt(0)" ::: "memory");
        } else {
            XB_SPIN(xb_ld(&bar[XB_XGEN(b.x)]) == gen, bar);
            __builtin_amdgcn_fence(__ATOMIC_ACQUIRE, "agent");
            asm volatile("s_waitcnt vmcnt(0)" ::: "memory");
        }
    }
    __syncthreads();
}
constexpr size_t WS_BARW = 102 * MiB;
#ifdef DBG
__device__ __noinline__ void dbg_scan(const void* ptr, size_t nbytes, int is_f32, unsigned code, unsigned* dbg, int gtid, int gthreads) {
    const u32x4* q = (const u32x4*)ptr; const size_t n = nbytes / 16; bool bad = false;
    for (size_t i = gtid; i < n; i += gthreads) { const u32x4 v = q[i];
#pragma unroll
        for (int e = 0; e < 4; ++e) { if (is_f32) bad |= ((v[e] & 0x7f800000u) == 0x7f800000u); else bad |= ((v[e] & 0x7f80u) == 0x7f80u) | ((v[e] & 0x7f800000u) == 0x7f800000u); } }
    if (bad) atomicMin(dbg, code);
}
#define SCAN(ptr, nbytes, isf, code) do { dbg_scan((ptr), (nbytes), (isf), (code), dbgw, bid * 512 + (int)threadIdx.x, G * 512); grid.sync(); } while (0)
#else
#define SCAN(ptr, nbytes, isf, code) do { } while (0)
#endif
constexpr int LDS_BYTES = 147456;
__global__ void __launch_bounds__(512, 2) mega_fwd(Params p) {
    extern __shared__ __attribute__((aligned(16))) unsigned char lds[];
    cg::grid_group grid = cg::this_grid();
    const int G = gridDim.x, bid = blockIdx.x; const int NGW = G * 8;
    int tid, lane, wave, gw;
#define FRESH() do { tid = threadIdx.x; asm volatile("" : "+v"(tid)); lane = tid & 63; wave = __builtin_amdgcn_readfirstlane(tid >> 6); gw = bid * 8 + wave; } while (0)
    FRESH();
    unsigned char* ws = p.ws;
    float* RSSP0 = (float*)(ws + WS_RSSP); float* RSSP1 = RSSP0 + RSSP_STRIDE;
    bf16_t* XB = (bf16_t*)(ws + WS_XB); bf16_t* BIG = (bf16_t*)(ws + WS_BIG);
#ifdef DBG
    unsigned* dbgw = (unsigned*)(ws + 102 * MiB + 65536);
#endif

#ifndef PH
#define PH 0xFFFF
#endif
#define ON(k) ((PH >> (k)) & 1)
#ifndef REP
#define REP 0
#endif
#define NREP(k) (((REP) >> (k)) & 1)
#define RUN(k, call) do { if (ON(k)) { for (int rep_ = NREP(k); rep_ >= 0; --rep_) { const int dry = rep_; (void)dry; FRESH(); call; if (rep_) grid.sync(); } } } while (0)
    { volatile LAS unsigned* bst_ = (volatile LAS unsigned*)(LAS unsigned char*)(lds + LDS_BYTES - 16); if (threadIdx.x == 0) { bst_[0] = 0u; bst_[1] = 0u; } }
    __syncthreads();
    const XcdBarrier xbar = xcd_barrier_post((unsigned*)(ws + WS_BARW), (volatile LAS unsigned*)(LAS unsigned char*)(lds + LDS_BYTES - 16));
    RUN(0, prep_phase(p, lds, gw, NGW, wave, lane));
#ifdef XSYNC
    for (int i_ = 0; i_ < XSYNC; ++i_) grid.sync();
#endif
    if (p.out == nullptr) grid.sync();
    xcd_barrier(xbar);
    SCAN(XB, (size_t)NTOK * DM * 2, 0, 1); SCAN(RSSP0, (size_t)NTOK * 16, 1, 2); SCAN(ws + WS_W, W_END - WS_W, 0, 3);
    for (int layer = 0; layer < 4; ++layer) {
        if (layer == 1) { RUN(1, pool_dlt_phase(p, lds, bid, G, tid)); }
        else if (layer == 2) {
            pg8::Sched S; S.init(128, 21, G, bid, 0, 256L * 2048, 0, 256L * 2048);
            pg8::EpiSsdIn E{BIG, RSSP0, (float*)(ws + WS_BIG + BIG_SSD_DT), p.in[I_SSD_CW], p.in[I_SSD_CB], (float*)((unsigned char*)p.out + XBR_HALO)};
            FRESH(); pg8::gemm_phase<pg8::EpiSsdIn>(lds, XB, (const bf16_t*)(ws + W_SSD_IN), 1024, 1024, S, E, tid);
        }
        else {
            pg8::Sched S; pg8::EpiProj E; const bf16_t* Bt;
            if (layer == 0) { Bt = (const bf16_t*)(ws + W_GLA_IN); S.init(128, 13, G, bid, 0, 256L * 2048, 0, 256L * 2048); E = pg8::EpiProj{BIG, 3072, RSSP0, 12, (float*)(ws + WS_BIG + BIG_GLA_GLR), 16}; }
            else if (layer == 2) { Bt = (const bf16_t*)(ws + W_SSD_IN); S.init(128, 21, G, bid, 0, 256L * 2048, 0, 256L * 2048); E = pg8::EpiProj{BIG, 5120, RSSP0, 20, (float*)(ws + WS_BIG + BIG_SSD_DT), 32}; }
            else { Bt = (const bf16_t*)(ws + W_SB_QKV); S.init(128, 12, G, bid, 0, 256L * 2048, 0, 256L * 2048); E = pg8::EpiProj{BIG, 3072, RSSP0, -1, nullptr, 0}; }
            RUN(2, pg8::gemm_phase<pg8::EpiProj>(lds, XB, Bt, 1024, 1024, S, E, tid));
        }
        xcd_barrier(xbar);
        if (layer == 0) { SCAN(BIG, (size_t)NTOK * 3072 * 2, 0, 10); SCAN(ws + WS_BIG + BIG_GLA_GLR, (size_t)NTOK * 64, 1, 11); }
        else if (layer == 1) { SCAN(BIG, (size_t)NTOK * 1024 * 2, 0, 20); }
        else if (layer == 2) { SCAN(BIG, (size_t)NTOK * 5120 * 2, 0, 30); SCAN(ws + WS_BIG + BIG_SSD_DT, (size_t)NTOK * 128, 1, 31); }
        else { SCAN(BIG, (size_t)NTOK * 3072 * 2, 0, 40); }
        if (layer == 0) { RUN(3, gla1_phase(p, lds, bid, G, tid)); xcd_barrier(xbar); SCAN(ws + WS_BIG + BIG_GLA_KDT, 32 * MiB, 0, 12); SCAN(ws + WS_XB, 64 * MiB, 0, 13); for (int gp_ = 1; gp_ <= 2; ++gp_) { FRESH(); gla_scan_phase(p, lds, bid, G, tid, wave, lane, gp_); if (gp_ == 1) { xcd_barrier(xbar); FRESH(); gla_combine_phase(p, bid, G, tid); xcd_barrier(xbar); } } xcd_barrier(xbar); SCAN(ws + WS_BIG + BIG_GLA_OPRE, 64 * MiB, 0, 14); if (ON(5)) { FRESH(); gla3_phase(p, gw, NGW, lane); } xcd_barrier(xbar); SCAN(ws + WS_BIG + BIG_GLA_OPRE, 64 * MiB, 0, 15); }
        else if (layer == 2) { FRESH(); ssd_dt_fix_phase(p, lds, bid, G, tid); xcd_barrier(xbar); RUN(6, ssd_scan_phase(p, lds, bid, G, tid, wave, lane, dry)); xcd_barrier(xbar); SCAN(BIG, (size_t)NTOK * 5120 * 2, 0, 32); if (ON(7)) { FRESH(); ssd3_phase(p, gw, NGW, lane); } xcd_barrier(xbar); SCAN(BIG, (size_t)NTOK * 5120 * 2, 0, 33); }
        else if (layer == 3) { RUN(8, sb_attn_phase(p, lds, bid, G, tid, wave, lane)); xcd_barrier(xbar); SCAN(ws + WS_BIG + BIG_SB_AO, 64 * MiB, 0, 41); }
        {
            pg8::Sched S; pg8::EpiResid E{XB, RSSP1, nullptr, nullptr, 0}; const bf16_t* A; const bf16_t* Bt; int lda, K;
            if (layer == 0) { A = (const bf16_t*)(ws + WS_BIG + BIG_GLA_OPRE); Bt = (const bf16_t*)(ws + W_GLA_OUT); lda = 1024; K = 1024; S.init(128, 4, G, bid, 0, 256L * 2048, 0, 256L * 2048); }
            else if (layer == 1) { A = BIG; Bt = (const bf16_t*)(ws + W_POOL); lda = 1024; K = 256; S.init(128, 4, G, bid, 0, 256L * 2048, 512, 256L * 512); E.bias = p.in[I_POOL_B]; E.scale = p.in[I_POOL_SC]; }
            else if (layer == 2) { A = BIG + 2048; Bt = (const bf16_t*)(ws + W_SSD_OUT); lda = 5120; K = 2048; S.init(128, 4, G, bid, 0, 256L * 10240, 0, 256L * 4096); }
            else { A = (const bf16_t*)(ws + WS_BIG + BIG_SB_AO); Bt = (const bf16_t*)(ws + W_SB_OUT); lda = 1024; K = 1024; S.init(128, 4, G, bid, 0, 256L * 2048, 0, 256L * 2048); }
            RUN(9, (E.dry = dry, pg8::gemm_phase<pg8::EpiResid>(lds, A, Bt, lda, K, S, E, tid)));
        }
        xcd_barrier(xbar);
        SCAN(p.out, (size_t)NTOK * DM * 4, 1, 10 * (layer + 1) + 5); SCAN(RSSP1, (size_t)NTOK * 16, 1, 10 * (layer + 1) + 6);
        {
            pg8::Sched S; S.init(128, 22, G, bid, 0, 256L * 2048, 0, 256L * 2048);
            pg8::EpiFfnUp E{BIG, RSSP1, p.in[I_FFN_CW] + (size_t)layer * 3 * 5632, p.in[I_FFN_CB] + (size_t)layer * 5632, (float*)(ws + WS_BIG + 176 * MiB)};
            RUN(10, pg8::gemm_phase<pg8::EpiFfnUp>(lds, XB, (const bf16_t*)(ws + WS_W + layer * W_FFN_STRIDE), 1024, 1024, S, E, tid));
        }
        xcd_barrier(xbar);
        FRESH(); ffn_fix_phase(p, layer, bid, G, tid);
        xcd_barrier(xbar);
        SCAN(BIG, (size_t)NTOK * FFD * 2, 0, 10 * (layer + 1) + 7);
        {
            pg8::Sched S; S.init(128, 4, G, bid, 0, 256L * 128, 0, 256L * 5632);
            pg8::EpiResid E{XB, RSSP0, nullptr, nullptr, 0};
            RUN(11, (E.dry = dry, pg8::gemm_phase<pg8::EpiResid>(lds, BIG, (const bf16_t*)(ws + WS_W + layer * W_FFN_STRIDE + W_FFN_DOWN_OFF), 64, FFD, S, E, tid, (size_t)NTOK * 128)));
        }
        xcd_barrier(xbar);
        SCAN(p.out, (size_t)NTOK * DM * 4, 1, 10 * (layer + 1) + 8);
    }
    if (ON(12)) { FRESH(); final_phase(p, gw, NGW, lane); }
#ifdef DBG
    xcd_barrier(xbar);
    if (bid == 0 && threadIdx.x == 0) { const unsigned dv = *dbgw; p.out[0] = dv > 1000u ? 0.f : 100.f * (float)dv; }
#endif
}

extern "C" void kernel_launch(void* const* d_in, const int* in_sizes, int n_in, void* d_out, int out_size, void* d_ws, size_t ws_size, hipStream_t stream) {
    static int grid = 0;
    if (grid == 0) {
        if (n_in != 26 || out_size != NTOK * DM || ws_size < WS_NEED) { fprintf(stderr, "kernel_launch: unexpected problem (n_in %d, out %d, ws %zu)\n", n_in, out_size, ws_size); grid = -1; return; }
        int dev = 0, cus = 0, per_cu = 0;
        hipGetDevice(&dev); hipDeviceGetAttribute(&cus, hipDeviceAttributeMultiprocessorCount, dev);
        hipFuncSetAttribute((const void*)mega_fwd, hipFuncAttributeMaxDynamicSharedMemorySize, LDS_BYTES);
        hipOccupancyMaxActiveBlocksPerMultiprocessor(&per_cu, (const void*)mega_fwd, 512, LDS_BYTES);
        if (per_cu < 1) per_cu = 1;
        grid = cus * 1;
        (void)hipGetLastError();
    }
    if (grid < 0) return;
    if (hipMemsetAsync((unsigned char*)d_ws + WS_BARW, 0, 16384, stream) != hipSuccess) { fprintf(stderr, "kernel_launch: memset failed\n"); return; }
    Params p{};
    for (int i = 0; i < 26; ++i) p.in[i] = (const float*)d_in[i];
    p.out = (float*)d_out; p.ws = (unsigned char*)d_ws;
#ifdef DBG
    hipMemsetAsync((unsigned char*)d_ws + 102 * MiB + 65536, 0x7f, 64, stream);
#endif
    void* args[] = {&p};
    hipError_t e = hipLaunchCooperativeKernel((const void*)mega_fwd, dim3(grid), dim3(512), args, LDS_BYTES, stream);
    if (e != hipSuccess) fprintf(stderr, "cooperative launch failed: %s (grid %d)\n", hipGetErrorString(e), grid);
}
```

```cpp
#include <hip/hip_runtime.h>
#include <hip/hip_cooperative_groups.h>
#include <cstdio>
#include <cstdint>
namespace cg = cooperative_groups;

#define LAS __attribute__((address_space(3)))
typedef unsigned short bf16_t;
typedef short bf16x8 __attribute__((ext_vector_type(8)));
typedef float f32x4 __attribute__((ext_vector_type(4)));
typedef unsigned u32x4 __attribute__((ext_vector_type(4)));
typedef unsigned u32x2 __attribute__((ext_vector_type(2)));

constexpr int NTOK = 32768, DM = 1024, SEQL = 4096;
constexpr int FFD = 2816;
constexpr size_t MiB = 1u << 20;
constexpr size_t WS_RSSP = 0;
constexpr size_t RSSP_STRIDE = (size_t)NTOK * 4;
constexpr size_t WS_W = 4 * MiB;
constexpr size_t W_FFN_STRIDE = 16 * MiB + MiB / 2;
constexpr size_t W_FFN_DOWN_OFF = 11 * MiB;
constexpr size_t W_GLA_IN = WS_W + 66 * MiB;
constexpr size_t W_GLA_OUT = W_GLA_IN + 6 * MiB + MiB / 2;
constexpr size_t W_POOL = W_GLA_OUT + 2 * MiB;
constexpr size_t W_SSD_IN = W_POOL + MiB / 2;
constexpr size_t W_SSD_OUT = W_SSD_IN + 10 * MiB + MiB / 2;
constexpr size_t W_SB_QKV = W_SSD_OUT + 4 * MiB;
constexpr size_t W_SB_OUT = W_SB_QKV + 6 * MiB;
constexpr size_t W_END = W_SB_OUT + 2 * MiB;
constexpr size_t WS_XB = 103 * MiB;
constexpr size_t WS_BIG = 168 * MiB;
constexpr size_t WS_NEED = 492 * MiB;
static_assert(W_END <= 102 * MiB, "weights map");
constexpr size_t BIG_GLA_KDT = 192 * MiB, BIG_GLA_EG = 224 * MiB, BIG_GLA_GLR = 225 * MiB, BIG_GLA_OPRE = 227 * MiB;
constexpr size_t BIG_SSD_DT = 320 * MiB;
constexpr size_t BIG_SB_AO = 192 * MiB;

typedef __bf16 bf2_t __attribute__((ext_vector_type(2)));
typedef float f2_t __attribute__((ext_vector_type(2)));
__device__ __forceinline__ unsigned cvt_pk_bf16(float lo, float hi) { f2_t v = {lo, hi}; bf2_t r = __builtin_convertvector(v, bf2_t); return __builtin_bit_cast(unsigned, r); }
__device__ __forceinline__ float bflo(unsigned w) { return __uint_as_float(w << 16); }
__device__ __forceinline__ float bfhi(unsigned w) { return __uint_as_float(w & 0xffff0000u); }
__device__ __forceinline__ float bf1(bf16_t h) { return __uint_as_float((unsigned)h << 16); }
__device__ __forceinline__ bf16_t f2bf(float f) { return (bf16_t)(cvt_pk_bf16(f, 0.f) & 0xffffu); }
__device__ __forceinline__ float fast_silu(float x) { return x * __builtin_amdgcn_rcpf(1.f + __expf(-x)); }
__device__ __forceinline__ float row_rstd(const float* rssp, int row) {
    const f32x4 a = *(const f32x4*)(rssp + (size_t)row * 4);
    const float s = (a.x + a.y) + (a.z + a.w);
    return rsqrtf(s * (1.0f / 1024.0f) + 1e-6f);
}
#define LBAR() do { asm volatile("s_waitcnt lgkmcnt(0)" ::: "memory"); __builtin_amdgcn_s_barrier(); asm volatile("" ::: "memory"); } while (0)
__device__ __forceinline__ int swz144(int r, int sb) { return r * 128 + ((((sb >> 4) ^ (((r >> 3) ^ (r >> 1)) & 7)) << 4) | (sb & 15)); }
#define MFMA16(a, b, c) __builtin_amdgcn_mfma_f32_16x16x32_bf16((a), (b), (c), 0, 0, 0)
__device__ __forceinline__ bf16x8 ldsfrag(const unsigned char* p) { return *(const bf16x8*)p; }

__device__ __forceinline__ float prev_lane16(float x) { const int v = __builtin_bit_cast(int, x); return __builtin_bit_cast(float, __builtin_amdgcn_update_dpp(v, v, 0x111  , 0xf, 0xf, false)); }
namespace pg8 {
constexpr int BM = 256, BK = 64, HALF = 128, HTB = HALF * BK * 2, STAGE_BYTES = 8 * HTB, NXCD = 8, WGM = 8;
__host__ __device__ __forceinline__ int lds_byte(int r, int c) { const int st = (r >> 4) * 2 + (c >> 5), rr = r & 15, cc = c & 31, ob = rr * 64 + cc * 2; return st * 1024 + (ob ^ (((ob >> 9) & 1) << 5)); }
__host__ __device__ __forceinline__ void stage_rc(int b, int& R, int& C) { const int st = b / 1024, sb = b % 1024, swz = sb ^ (((sb >> 9) & 1) << 5); R = (st >> 1) * 16 + swz / 64; C = (st & 1) * 32 + (swz % 64) / 2; }
__host__ __device__ __forceinline__ int perm32(int rho) { const int n = rho >> 4, i = rho & 15; return 8 * (i >> 2) + 4 * n + (i & 3); }

struct Unit { int pm, pn; long a_off, b_off; };

struct Sched {
    int nM, nN, nwg, G, c, mode; long a_tile, a_pn, b_tile;
    __device__ __forceinline__ void init(int nM_, int nN_, int G_, int c_, int mode_, long a_tile_, long a_pn_, long b_tile_) { nM = nM_; nN = nN_; nwg = nM * nN; G = G_; c = c_; mode = mode_; a_tile = a_tile_; a_pn = a_pn_; b_tile = b_tile_; }
    __device__ __forceinline__ bool next(int i, Unit& u) const {
        const long L = (long)i * G + c; if (L >= nwg) return false;
        int wgid = (int)L; { const int q = nwg / NXCD, r = nwg % NXCD, xcd = wgid % NXCD, off = wgid / NXCD; wgid = (xcd < r ? xcd * (q + 1) : r * (q + 1) + (xcd - r) * q) + off; }
        const int nig = WGM * nN, gid = wgid / nig, fm = gid * WGM, gsz = (nM - fm) < WGM ? (nM - fm) : WGM;
        u.pm = fm + ((wgid % nig) % gsz); u.pn = (wgid % nig) / gsz;
        if (mode == 0) u.a_off = (long)u.pm * a_tile + (long)u.pn * a_pn;
        else { const int b = u.pm / 17, ii = u.pm - b * 17; u.a_off = ((long)b * 4096 + 254 * ii - 2) * 2048; }
        u.b_off = (long)u.pn * b_tile; return true;
    }
};

struct EpiProj {
    static constexpr bool PERM = true, APERM = false;
    bf16_t* O; int ldc; const float* rssp; int sp_tile; float* sp_out; int sp_ld;
    __device__ __forceinline__ bool narrow(const Unit& u) const { return u.pn == sp_tile; }
    __device__ __forceinline__ void operator()(f32x4 (&acc)[2][2][4][2], const Unit& u, int wr, int wc, int fr, int fq, unsigned char* lds) const {
        const int row0 = u.pm * BM + wr * 64 + fr;
        float rs[2][4];
#pragma unroll
        for (int ai = 0; ai < 2; ++ai)
#pragma unroll
            for (int m = 0; m < 4; ++m) rs[ai][m] = row_rstd(rssp, row0 + ai * HALF + m * 16);
        if (u.pn == sp_tile) {
            if (wc == 0) {
#pragma unroll
                for (int ai = 0; ai < 2; ++ai)
#pragma unroll
                    for (int m = 0; m < 4; ++m)
#pragma unroll
                        for (int n = 0; n < 2; ++n) { const int c = 8 * fq + 4 * n; if (c < sp_ld) *(f32x4*)(sp_out + (size_t)(row0 + ai * HALF + m * 16) * sp_ld + c) = acc[ai][0][m][n] * rs[ai][m]; }
            }
            return;
        }
        const int col0 = u.pn * BM + wc * 32 + 8 * fq;
#pragma unroll
        for (int ai = 0; ai < 2; ++ai)
#pragma unroll
            for (int m = 0; m < 4; ++m) { bf16_t* rowp = O + (size_t)(row0 + ai * HALF + m * 16) * ldc + col0; const float s = rs[ai][m];
#pragma unroll
                for (int bj = 0; bj < 2; ++bj) { const f32x4 v0 = acc[ai][bj][m][0] * s, v1 = acc[ai][bj][m][1] * s;
                    u32x4 w; w.x = cvt_pk_bf16(v0[0], v0[1]); w.y = cvt_pk_bf16(v0[2], v0[3]); w.z = cvt_pk_bf16(v1[0], v1[1]); w.w = cvt_pk_bf16(v1[2], v1[3]);
                    *(u32x4*)(rowp + bj * HALF) = w; } }
    }
};

struct EpiSsdIn {
    static constexpr bool PERM = true, APERM = true;
    bf16_t* O; const float* rssp; float* dt_out; const float* cw; const float* cb; float* side;
    __device__ __forceinline__ bool narrow(const Unit& u) const { return u.pn == 20; }
    __device__ __forceinline__ void operator()(f32x4 (&acc)[2][2][4][2], const Unit& u, int wr, int wc, int fr, int fq, unsigned char* lds) const {
        const int ii = u.pm & 15; const int rowbase = u.pm * BM;
        float* bnd = (float*)(lds + STAGE_BYTES);
#pragma unroll
        for (int ai = 0; ai < 2; ++ai)
#pragma unroll
            for (int m = 0; m < 4; ++m) { const float rs = row_rstd(rssp, rowbase + ai * HALF + wr * 64 + 4 * fr + m);
#pragma unroll
                for (int bj = 0; bj < 2; ++bj)
#pragma unroll
                    for (int n = 0; n < 2; ++n) acc[ai][bj][m][n] = acc[ai][bj][m][n] * rs; }
        const bool convt = (u.pn >= 8 && u.pn < 20);
        if (convt) {
            const int xc0 = (u.pn - 8) * 256 + wc * 32 + 8 * fq;
            if (fr == 15) {
#pragma unroll
                for (int ai = 0; ai < 2; ++ai)
#pragma unroll
                    for (int mm = 0; mm < 3; ++mm)
#pragma unroll
                        for (int bj = 0; bj < 2; ++bj)
#pragma unroll
                            for (int n = 0; n < 2; ++n) *(f32x4*)(bnd + ((ai * 2 + wr) * 3 + mm) * 256 + bj * HALF + wc * 32 + 8 * fq + 4 * n) = acc[ai][bj][1 + mm][n];
                if (wr == 1) {
#pragma unroll
                    for (int mm = 0; mm < 3; ++mm)
#pragma unroll
                        for (int bj = 0; bj < 2; ++bj)
#pragma unroll
                            for (int n = 0; n < 2; ++n) *(f32x4*)(side + ((size_t)u.pm * 6 + 3 + mm) * 3072 + xc0 + bj * HALF + 4 * n) = acc[1][bj][1 + mm][n];
                }
            }
            if (fr == 0 && wr == 0) {
#pragma unroll
                for (int mm = 0; mm < 3; ++mm)
#pragma unroll
                    for (int bj = 0; bj < 2; ++bj)
#pragma unroll
                        for (int n = 0; n < 2; ++n) *(f32x4*)(side + ((size_t)u.pm * 6 + mm) * 3072 + xc0 + bj * HALF + 4 * n) = acc[0][bj][mm][n];
            }
        }
        asm volatile("s_waitcnt lgkmcnt(0)" ::: "memory"); __builtin_amdgcn_s_barrier(); asm volatile("" ::: "memory");
        if (convt) {
            const int xc0 = (u.pn - 8) * 256 + wc * 32 + 8 * fq;
#pragma unroll
            for (int bj = 0; bj < 2; ++bj)
#pragma unroll
                for (int n = 0; n < 2; ++n) { const int xc = xc0 + bj * HALF + 4 * n;
                    const f32x4 w0 = *(const f32x4*)(cw + xc), w1 = *(const f32x4*)(cw + 3072 + xc), w2 = *(const f32x4*)(cw + 2 * 3072 + xc), w3 = *(const f32x4*)(cw + 3 * 3072 + xc), bb = *(const f32x4*)(cb + xc);
#pragma unroll
                    for (int ai = 0; ai < 2; ++ai) { const int pblk = ai * 2 + wr - 1;
                        f32x4 p1, p2, p3;
#pragma unroll
                        for (int e = 0; e < 4; ++e) { p1[e] = prev_lane16(acc[ai][bj][1][n][e]); p2[e] = prev_lane16(acc[ai][bj][2][n][e]); p3[e] = prev_lane16(acc[ai][bj][3][n][e]); }
                        if (fr == 0) { if (pblk >= 0) { const float* bp = bnd + (pblk * 3) * 256 + bj * HALF + wc * 32 + 8 * fq + 4 * n; p1 = *(const f32x4*)(bp); p2 = *(const f32x4*)(bp + 256); p3 = *(const f32x4*)(bp + 512); }
                                       else { p1 = (f32x4){0.f, 0.f, 0.f, 0.f}; p2 = p1; p3 = p1; } }
                        const f32x4 v0 = acc[ai][bj][0][n], v1 = acc[ai][bj][1][n], v2 = acc[ai][bj][2][n], v3 = acc[ai][bj][3][n];
                        f32x4 o[4];
                        o[0] = bb + w3 * v0 + w2 * p3 + w1 * p2 + w0 * p1; o[1] = bb + w3 * v1 + w2 * v0 + w1 * p3 + w0 * p2;
                        o[2] = bb + w3 * v2 + w2 * v1 + w1 * v0 + w0 * p3; o[3] = bb + w3 * v3 + w2 * v2 + w1 * v1 + w0 * v0;
#pragma unroll
                        for (int m = 0; m < 4; ++m) { const int tau = ai * HALF + wr * 64 + 4 * fr + m;
                            if (tau >= 3 || ii == 0) { u32x2 w; w.x = cvt_pk_bf16(fast_silu(o[m][0]), fast_silu(o[m][1])); w.y = cvt_pk_bf16(fast_silu(o[m][2]), fast_silu(o[m][3]));
                                *(u32x2*)(O + (size_t)(rowbase + tau) * 5120 + 2048 + xc) = w; } } } }
        } else if (u.pn == 20) {
            if (wc == 0) {
#pragma unroll
                for (int ai = 0; ai < 2; ++ai)
#pragma unroll
                    for (int m = 0; m < 4; ++m)
#pragma unroll
                        for (int n = 0; n < 2; ++n) *(f32x4*)(dt_out + (size_t)(rowbase + ai * HALF + wr * 64 + 4 * fr + m) * 32 + 8 * fq + 4 * n) = acc[ai][0][m][n];
            }
        } else {
            const int col0 = u.pn * BM + wc * 32 + 8 * fq;
#pragma unroll
            for (int ai = 0; ai < 2; ++ai)
#pragma unroll
                for (int m = 0; m < 4; ++m) { bf16_t* rowp = O + (size_t)(rowbase + ai * HALF + wr * 64 + 4 * fr + m) * 5120 + col0;
#pragma unroll
                    for (int bj = 0; bj < 2; ++bj) { const f32x4 v0 = acc[ai][bj][m][0], v1 = acc[ai][bj][m][1];
                        u32x4 w; w.x = cvt_pk_bf16(v0[0], v0[1]); w.y = cvt_pk_bf16(v0[2], v0[3]); w.z = cvt_pk_bf16(v1[0], v1[1]); w.w = cvt_pk_bf16(v1[2], v1[3]);
                        *(u32x4*)(rowp + bj * HALF) = w; } }
        }
    }
};

struct EpiResid {
    static constexpr bool PERM = true, APERM = false;
    bf16_t* xb; float* rssp_out; const float* bias; const float* scale; int dry;
    __device__ __forceinline__ bool narrow(const Unit&) const { return false; }
    __device__ __forceinline__ void operator()(f32x4 (&acc)[2][2][4][2], const Unit& u, int wr, int wc, int fr, int fq, unsigned char* lds) const {
        const int col0 = u.pn * BM + wc * 32 + 8 * fq;
        float* part = (float*)(lds + STAGE_BYTES);
        if (bias) {
#pragma unroll
            for (int bj = 0; bj < 2; ++bj)
#pragma unroll
                for (int n = 0; n < 2; ++n) { const f32x4 bv = *(const f32x4*)(bias + col0 + bj * HALF + 4 * n), sv = *(const f32x4*)(scale + col0 + bj * HALF + 4 * n);
#pragma unroll
                    for (int ai = 0; ai < 2; ++ai)
#pragma unroll
                        for (int m = 0; m < 4; ++m) acc[ai][bj][m][n] = (acc[ai][bj][m][n] + bv) * sv; }
        }
#pragma unroll
        for (int ai = 0; ai < 2; ++ai) {
            u32x4 xo[4][2];
#pragma unroll
            for (int m = 0; m < 4; ++m)
#pragma unroll
                for (int bj = 0; bj < 2; ++bj) xo[m][bj] = *(const u32x4*)(xb + (size_t)(u.pm * BM + ai * HALF + wr * 64 + m * 16 + fr) * DM + col0 + bj * HALF);
#pragma unroll
            for (int m = 0; m < 4; ++m) { const int row = u.pm * BM + ai * HALF + wr * 64 + m * 16 + fr; bf16_t* rp = xb + (size_t)row * DM + col0; float ss = 0.f;
#pragma unroll
                for (int bj = 0; bj < 2; ++bj) { const u32x4 xv = xo[m][bj]; const f32x4 v0 = acc[ai][bj][m][0], v1 = acc[ai][bj][m][1];
                    const float x0 = bflo(xv.x) + v0[0], x1 = bfhi(xv.x) + v0[1], x2 = bflo(xv.y) + v0[2], x3 = bfhi(xv.y) + v0[3];
                    const float x4 = bflo(xv.z) + v1[0], x5 = bfhi(xv.z) + v1[1], x6 = bflo(xv.w) + v1[2], x7 = bfhi(xv.w) + v1[3];
                    ss += ((x0 * x0 + x1 * x1) + (x2 * x2 + x3 * x3)) + ((x4 * x4 + x5 * x5) + (x6 * x6 + x7 * x7));
                    u32x4 w; w.x = cvt_pk_bf16(x0, x1); w.y = cvt_pk_bf16(x2, x3); w.z = cvt_pk_bf16(x4, x5); w.w = cvt_pk_bf16(x6, x7);
                    if (!dry) *(u32x4*)(rp + bj * HALF) = w; }
                ss += __shfl_xor(ss, 16); ss += __shfl_xor(ss, 32);
                if (fq == 0) part[wc * 256 + ai * HALF + wr * 64 + m * 16 + fr] = ss; }
        }
        asm volatile("s_waitcnt lgkmcnt(0)" ::: "memory"); __builtin_amdgcn_s_barrier(); asm volatile("" ::: "memory");
        { const int t = (wr * 4 + wc) * 64 + fq * 16 + fr;
          if (t < 256 && !dry) rssp_out[(size_t)(u.pm * BM + t) * 4 + u.pn] = (part[t] + part[256 + t]) + (part[512 + t] + part[768 + t]); }
    }
};

struct EpiFfnUp {
    static constexpr bool PERM = true, APERM = true;
    bf16_t* act; const float* rssp; const float* cw; const float* cb; float* side;
    __device__ __forceinline__ bool narrow(const Unit&) const { return false; }
    __device__ __forceinline__ void operator()(f32x4 (&acc)[2][2][4][2], const Unit& u, int wr, int wc, int fr, int fq, unsigned char* lds) const {
        const int ii = u.pm & 15; const int rowbase = u.pm * BM;
        float* bnd = (float*)(lds + STAGE_BYTES);
        const int ch0 = u.pn * 128 + wc * 32 + 8 * fq;
        f32x4 wq[8];
        wq[0] = *(const f32x4*)(cw + ch0); wq[1] = *(const f32x4*)(cw + 5632 + ch0); wq[2] = *(const f32x4*)(cw + 2 * 5632 + ch0); wq[3] = *(const f32x4*)(cb + ch0);
        wq[4] = *(const f32x4*)(cw + FFD + ch0); wq[5] = *(const f32x4*)(cw + 5632 + FFD + ch0); wq[6] = *(const f32x4*)(cw + 2 * 5632 + FFD + ch0); wq[7] = *(const f32x4*)(cb + FFD + ch0);
#pragma unroll
        for (int ai = 0; ai < 2; ++ai)
#pragma unroll
            for (int m = 0; m < 4; ++m) { const float rs = row_rstd(rssp, rowbase + ai * HALF + wr * 64 + 4 * fr + m);
#pragma unroll
                for (int bj = 0; bj < 2; ++bj)
#pragma unroll
                    for (int n = 0; n < 2; ++n) acc[ai][bj][m][n] = acc[ai][bj][m][n] * rs; }
        if (fr == 15) {
#pragma unroll
            for (int ai = 0; ai < 2; ++ai)
#pragma unroll
                for (int mm = 0; mm < 2; ++mm)
#pragma unroll
                    for (int bj = 0; bj < 2; ++bj)
#pragma unroll
                        for (int n = 0; n < 2; ++n) *(f32x4*)(bnd + ((ai * 2 + wr) * 2 + mm) * 256 + bj * HALF + wc * 32 + 8 * fq + 4 * n) = acc[ai][bj][2 + mm][n];
            if (wr == 1) {
#pragma unroll
                for (int mm = 0; mm < 2; ++mm)
#pragma unroll
                    for (int bj = 0; bj < 2; ++bj)
#pragma unroll
                        for (int n = 0; n < 2; ++n) *(f32x4*)(side + ((size_t)u.pm * 4 + 2 + mm) * 5632 + u.pn * 256 + bj * HALF + wc * 32 + 8 * fq + 4 * n) = acc[1][bj][2 + mm][n];
            }
        }
        if (fr == 0 && wr == 0) {
#pragma unroll
            for (int mm = 0; mm < 2; ++mm)
#pragma unroll
                for (int bj = 0; bj < 2; ++bj)
#pragma unroll
                    for (int n = 0; n < 2; ++n) *(f32x4*)(side + ((size_t)u.pm * 4 + mm) * 5632 + u.pn * 256 + bj * HALF + wc * 32 + 8 * fq + 4 * n) = acc[0][bj][mm][n];
        }
        asm volatile("s_waitcnt lgkmcnt(0)" ::: "memory"); __builtin_amdgcn_s_barrier(); asm volatile("" ::: "memory");
#pragma unroll
        for (int n = 0; n < 2; ++n) {
            if (n == 1) { wq[0] = *(const f32x4*)(cw + ch0 + 4); wq[1] = *(const f32x4*)(cw + 5632 + ch0 + 4); wq[2] = *(const f32x4*)(cw + 2 * 5632 + ch0 + 4); wq[3] = *(const f32x4*)(cb + ch0 + 4);
                          wq[4] = *(const f32x4*)(cw + FFD + ch0 + 4); wq[5] = *(const f32x4*)(cw + 5632 + FFD + ch0 + 4); wq[6] = *(const f32x4*)(cw + 2 * 5632 + FFD + ch0 + 4); wq[7] = *(const f32x4*)(cb + FFD + ch0 + 4); }
#pragma unroll
            for (int ai = 0; ai < 2; ++ai) {
                const int pblk = ai * 2 + wr - 1;
                float outv[4][4];
                {
                const f32x4 w0g = wq[0], w1g = wq[1], w2g = wq[2], bg = wq[3];
                f32x4 p2g, p3g;
#pragma unroll
                for (int e = 0; e < 4; ++e) { p2g[e] = prev_lane16(acc[ai][0][2][n][e]); p3g[e] = prev_lane16(acc[ai][0][3][n][e]); }
                if (fr == 0) { if (pblk >= 0) { const float* bp = bnd + (pblk * 2) * 256 + wc * 32 + 8 * fq + 4 * n; p2g = *(const f32x4*)(bp); p3g = *(const f32x4*)(bp + 256); } else { p2g = (f32x4){0.f, 0.f, 0.f, 0.f}; p3g = p2g; } }
                const f32x4 g0 = acc[ai][0][0][n], g1 = acc[ai][0][1][n], g2 = acc[ai][0][2][n], g3 = acc[ai][0][3][n];
                const f32x4 cg0 = bg + w2g * g0 + w1g * p3g + w0g * p2g, cg1 = bg + w2g * g1 + w1g * g0 + w0g * p3g, cg2 = bg + w2g * g2 + w1g * g1 + w0g * g0, cg3 = bg + w2g * g3 + w1g * g2 + w0g * g1;
#pragma unroll
                for (int e = 0; e < 4; ++e) { outv[0][e] = fast_silu(cg0[e]); outv[1][e] = fast_silu(cg1[e]); outv[2][e] = fast_silu(cg2[e]); outv[3][e] = fast_silu(cg3[e]); }
                }
                {
                const f32x4 w0v = wq[4], w1v = wq[5], w2v = wq[6], bv = wq[7];
                f32x4 p2v, p3v;
#pragma unroll
                for (int e = 0; e < 4; ++e) { p2v[e] = prev_lane16(acc[ai][1][2][n][e]); p3v[e] = prev_lane16(acc[ai][1][3][n][e]); }
                if (fr == 0) { if (pblk >= 0) { const float* bp = bnd + (pblk * 2) * 256 + HALF + wc * 32 + 8 * fq + 4 * n; p2v = *(const f32x4*)(bp); p3v = *(const f32x4*)(bp + 256); } else { p2v = (f32x4){0.f, 0.f, 0.f, 0.f}; p3v = p2v; } }
                const f32x4 v0 = acc[ai][1][0][n], v1 = acc[ai][1][1][n], v2 = acc[ai][1][2][n], v3 = acc[ai][1][3][n];
                const f32x4 cv0 = bv + w2v * v0 + w1v * p3v + w0v * p2v, cv1 = bv + w2v * v1 + w1v * v0 + w0v * p3v, cv2 = bv + w2v * v2 + w1v * v1 + w0v * v0, cv3 = bv + w2v * v3 + w1v * v2 + w0v * v1;
#pragma unroll
                for (int e = 0; e < 4; ++e) { outv[0][e] *= cv0[e]; outv[1][e] *= cv1[e]; outv[2][e] *= cv2[e]; outv[3][e] *= cv3[e]; }
                }
#pragma unroll
                for (int m = 0; m < 4; ++m) { const int tau = ai * HALF + wr * 64 + 4 * fr + m;
                    if (tau >= 2 || ii == 0) { u32x2 w; w.x = cvt_pk_bf16(outv[m][0], outv[m][1]); w.y = cvt_pk_bf16(outv[m][2], outv[m][3]);
                        *(u32x2*)(act + ((size_t)((ch0 + 4 * n) >> 6) * NTOK + (rowbase + tau)) * 64 + ((ch0 + 4 * n) & 63)) = w; } }
            }
        }
    }
};

template <class Epi>
__device__ __forceinline__ void gemm_phase(unsigned char* lds_g, const bf16_t* Ag, const bf16_t* Btg, int lda, int K, const Sched& S, const Epi& E, int tid, size_t kstepA = 128) {
    LAS unsigned char* lds = (LAS unsigned char*)lds_g;
    const int wid = __builtin_amdgcn_readfirstlane(tid >> 6), lane = tid & 63, wr = wid >> 2, wc = wid & 3, fr = lane & 15, fq = lane >> 4;
    const int nt = K / BK;
    unsigned voffA[2], voffB[2];
#pragma unroll
    for (int i = 0; i < 2; ++i) { int R, C; stage_rc(tid * 16 + i * 8192, R, C);
        const int Rb = Epi::PERM ? ((R & ~31) + perm32(R & 31)) : R;
        const int Ra = Epi::APERM ? ((R & 64) + 4 * (R & 15) + ((R >> 4) & 3)) : R;
        voffA[i] = (unsigned)(Ra * lda + C) * 2u; voffB[i] = (unsigned)(Rb * K + C) * 2u; }
    const size_t kstep = (size_t)(BK * 2);
    const size_t hstepA = (size_t)HALF * lda * 2, hstepB = (size_t)HALF * K * 2;
    const unsigned ldsw = (unsigned)wid * 1024u;
    const int aoff = lds_byte(wr * 64 + fr, fq * 8), boff = lds_byte(wc * 32 + fr, fq * 8);
#define PG8_SA(b, h) (((b) * 2 + (h)) * HTB)
#define PG8_SB(b, h) ((4 + (b) * 2 + (h)) * HTB)
#define PG8_STAGE(bufoff, gbase, voff) do { _Pragma("unroll") for (int _i = 0; _i < 2; ++_i) \
        __builtin_amdgcn_global_load_lds((const unsigned*)((const char*)(gbase) + (voff)[_i]), (LAS unsigned*)(lds + (bufoff) + ldsw + _i * 8192), 16, 0, 0); } while (0)
#define PG8_LDA(dst, b, h) do { _Pragma("unroll") for (int m = 0; m < 4; ++m) _Pragma("unroll") for (int k = 0; k < 2; ++k) dst[m][k] = *(const LAS bf16x8*)(lds + PG8_SA(b, h) + aoff + m * 2048 + k * 1024); } while (0)
#define PG8_LDB(dst, b, h) do { _Pragma("unroll") for (int n = 0; n < 2; ++n) _Pragma("unroll") for (int k = 0; k < 2; ++k) dst[n][k] = *(const LAS bf16x8*)(lds + PG8_SB(b, h) + boff + n * 2048 + k * 1024); } while (0)
#define PG8_MMA(ai, bj, At, Bt) do { __builtin_amdgcn_s_setprio(1); _Pragma("unroll") for (int m = 0; m < 4; ++m) _Pragma("unroll") for (int n = 0; n < 2; ++n) _Pragma("unroll") for (int k = 0; k < 2; ++k) \
        acc[ai][bj][m][n] = __builtin_amdgcn_mfma_f32_16x16x32_bf16(Bt[n][k], At[m][k], acc[ai][bj][m][n], 0, 0, 0); __builtin_amdgcn_s_setprio(0); } while (0)
#define PG8_WAIT_V(n) asm volatile("s_waitcnt vmcnt(" #n ")" ::: "memory")
#define PG8_WAIT_L(n) asm volatile("s_waitcnt lgkmcnt(" #n ")" ::: "memory")
#define PG8_BAR __builtin_amdgcn_s_barrier()
#define PG8_SCHED __builtin_amdgcn_sched_barrier(0)
    Unit cur, nxt; int ui = 0;
    if (!S.next(0, cur)) return;
    f32x4 acc[2][2][4][2];
#pragma unroll
    for (int a = 0; a < 2; ++a)
#pragma unroll
        for (int b = 0; b < 2; ++b)
#pragma unroll
            for (int m = 0; m < 4; ++m)
#pragma unroll
                for (int n = 0; n < 2; ++n) acc[a][b][m][n] = (f32x4){0.f, 0.f, 0.f, 0.f};
    bf16x8 At[4][2], B0[2][2], B1[2][2];
    const char* cA = (const char*)Ag + cur.a_off; const char* cB = (const char*)Btg + cur.b_off;
    PG8_STAGE(PG8_SB(0, 0), cB, voffB); PG8_STAGE(PG8_SB(0, 1), cB + hstepB, voffB); PG8_STAGE(PG8_SA(0, 0), cA, voffA); PG8_STAGE(PG8_SA(0, 1), cA + hstepA, voffA);
    if (wr == 1) PG8_BAR;
    PG8_WAIT_V(2); PG8_BAR;
    PG8_STAGE(PG8_SB(1, 0), cB + kstep, voffB); PG8_STAGE(PG8_SA(1, 0), cA + kstepA, voffA); PG8_STAGE(PG8_SB(1, 1), cB + hstepB + kstep, voffB);
    PG8_WAIT_V(6); PG8_BAR;
    for (;;) {
        const bool narrow = E.narrow(cur);
        const bool has_next = S.next(ui + 1, nxt);
        const char* nA = has_next ? (const char*)Ag + nxt.a_off : cA; const char* nB = has_next ? (const char*)Btg + nxt.b_off : cB;
        for (int t = 0; t < nt; t += 2) {
            const bool last = (t == nt - 2);
            const char* a1 = cA + (size_t)(t + 1) * kstepA;
            const char* a2 = last ? nA : cA + (size_t)(t + 2) * kstepA; const char* b2 = last ? nB : cB + (size_t)(t + 2) * kstep;
            const char* a3 = a2 + kstepA; const char* b3 = b2 + kstep;
            PG8_LDB(B0, 0, 0); PG8_LDB(B1, 0, 1); PG8_SCHED; PG8_LDA(At, 0, 0); PG8_STAGE(PG8_SA(1, 1), a1 + hstepA, voffA);
            PG8_WAIT_V(8); PG8_WAIT_L(0); PG8_BAR; PG8_MMA(0, 0, At, B0); if (!narrow) PG8_MMA(0, 1, At, B1); PG8_BAR; PG8_SCHED;
            PG8_LDA(At, 0, 1); PG8_STAGE(PG8_SB(0, 0), b2, voffB); PG8_STAGE(PG8_SB(0, 1), b2 + hstepB, voffB); PG8_STAGE(PG8_SA(0, 0), a2, voffA);
            PG8_WAIT_V(8); PG8_WAIT_L(0); PG8_BAR; PG8_MMA(1, 0, At, B0); if (!narrow) PG8_MMA(1, 1, At, B1); PG8_BAR; PG8_SCHED;
            PG8_LDB(B0, 1, 0); PG8_LDB(B1, 1, 1); PG8_SCHED; PG8_LDA(At, 1, 0); PG8_STAGE(PG8_SA(0, 1), a2 + hstepA, voffA);
            PG8_WAIT_V(8); PG8_WAIT_L(0); PG8_BAR; PG8_MMA(0, 0, At, B0); if (!narrow) PG8_MMA(0, 1, At, B1); PG8_BAR; PG8_SCHED;
            PG8_LDA(At, 1, 1); PG8_STAGE(PG8_SB(1, 0), b3, voffB); PG8_STAGE(PG8_SB(1, 1), b3 + hstepB, voffB); PG8_STAGE(PG8_SA(1, 0), a3, voffA);
            PG8_WAIT_V(8); PG8_WAIT_L(0); PG8_BAR; PG8_MMA(1, 0, At, B0); if (!narrow) PG8_MMA(1, 1, At, B1); PG8_BAR; PG8_SCHED;
        }
        if (wr == 0) PG8_BAR;
        E(acc, cur, wr, wc, fr, fq, lds_g);
        if (!has_next) break;
#pragma unroll
        for (int a = 0; a < 2; ++a)
#pragma unroll
            for (int b = 0; b < 2; ++b)
#pragma unroll
                for (int m = 0; m < 4; ++m)
#pragma unroll
                    for (int n = 0; n < 2; ++n) acc[a][b][m][n] = (f32x4){0.f, 0.f, 0.f, 0.f};
        cur = nxt; cA = nA; cB = nB; ++ui;
        if (wr == 1) PG8_BAR;
    }
    PG8_WAIT_V(0);
    PG8_BAR;
#undef PG8_SA
#undef PG8_SB
#undef PG8_STAGE
#undef PG8_LDA
#undef PG8_LDB
#undef PG8_MMA
#undef PG8_WAIT_V
#undef PG8_WAIT_L
#undef PG8_BAR
#undef PG8_SCHED
}
}

struct Params { const float* in[26]; float* out; unsigned char* ws; };
enum { I_X = 0, I_MIXNW, I_FFNNW, I_FINNW, I_GLA_WIN, I_GLA_WG2, I_GLA_BG, I_GLA_NW, I_GLA_WOUT, I_POOL_W, I_POOL_B, I_POOL_SC,
       I_SSD_WIN, I_SSD_CW, I_SSD_CB, I_SSD_DTB, I_SSD_ALOG, I_SSD_D, I_SSD_NW, I_SSD_WOUT, I_SB_WQKV, I_SB_WOUT, I_FFN_WUP, I_FFN_CW, I_FFN_CB, I_FFN_WDOWN };

struct TrItem { const float* W; int K, N; bf16_t* dst; int drow, n0, k0; const float* ks; float cs; };
__device__ __forceinline__ void tr_load(const TrItem& t, float (&v)[64], int lane) {
    const int n = t.n0 + lane; const bool ok = n < t.N;
#pragma unroll
    for (int kk = 0; kk < 64; ++kk) v[kk] = ok ? __builtin_nontemporal_load(t.W + (size_t)(t.k0 + kk) * t.N + n) : 0.f;
}
__device__ __forceinline__ void tr_store(const TrItem& t, const float (&v)[64], float* scr, int lane) {
#pragma unroll
    for (int kk = 0; kk < 64; ++kk) { float x = v[kk]; if (t.ks) x *= t.ks[t.k0 + kk]; scr[kk * 65 + lane] = x * t.cs; }
    asm volatile("s_waitcnt lgkmcnt(0)" ::: "memory");
    const int c = lane & 7;
#pragma unroll
    for (int j = 0; j < 8; ++j) { const int nn = (lane >> 3) + 8 * j; const float* s = scr + (8 * c) * 65 + nn;
        u32x4 o; o.x = cvt_pk_bf16(s[0], s[65]); o.y = cvt_pk_bf16(s[2 * 65], s[3 * 65]); o.z = cvt_pk_bf16(s[4 * 65], s[5 * 65]); o.w = cvt_pk_bf16(s[6 * 65], s[7 * 65]);
        *(u32x4*)(t.dst + (size_t)(t.drow + nn) * t.K + t.k0 + 8 * c) = o; }
    asm volatile("s_waitcnt lgkmcnt(0)" ::: "memory");
}
constexpr int I_UP = 16 * 88, I_DOWN = 44 * 16, I_GIN = 16 * 52, I_SQ = 16 * 16, I_POOLG = 4 * 4, I_SIN = 16 * 84, I_SOUT = 32 * 16, I_QKV = 16 * 48;
constexpr int NITEMS = 4 * I_UP + 4 * I_DOWN + I_GIN + I_SQ + 4 * I_POOLG + I_SIN + I_SOUT + I_QKV + I_SQ;
__device__ __forceinline__ TrItem tr_desc(const Params& p, int it) {
    unsigned char* ws = p.ws; int r = it;
    if (r < 4 * I_UP) { const int l = r / I_UP; r -= l * I_UP; const int kb = r / 88, nb = r % 88; const int n0 = nb * 64; const int half = n0 / FFD, cidx = n0 - half * FFD; const int drow = (cidx >> 7) * 256 + half * 128 + (cidx & 127);
        return TrItem{p.in[I_FFN_WUP] + (size_t)l * 1024 * 5632, 1024, 5632, (bf16_t*)(ws + WS_W + l * W_FFN_STRIDE), drow, n0, kb * 64, p.in[I_FFNNW] + l * 1024, 1.f}; } r -= 4 * I_UP;
    if (r < 4 * I_DOWN) { const int l = r / I_DOWN; r -= l * I_DOWN; const int kb = r / 16, nb = r % 16;
        return TrItem{p.in[I_FFN_WDOWN] + (size_t)l * FFD * 1024, FFD, 1024, (bf16_t*)(ws + WS_W + l * W_FFN_STRIDE + W_FFN_DOWN_OFF), nb * 64, nb * 64, kb * 64, nullptr, 1.f}; } r -= 4 * I_DOWN;
    if (r < I_GIN) { const int kb = r / 52, nb = r % 52; const int n0 = nb * 64;
        return TrItem{p.in[I_GLA_WIN], 1024, 3088, (bf16_t*)(ws + W_GLA_IN), n0, n0, kb * 64, p.in[I_MIXNW], n0 < 512 ? 0.08838834764831845f : 1.f}; } r -= I_GIN;
    if (r < I_SQ) { const int kb = r / 16, nb = r % 16;
        return TrItem{p.in[I_GLA_WOUT], 1024, 1024, (bf16_t*)(ws + W_GLA_OUT), nb * 64, nb * 64, kb * 64, nullptr, 1.f}; } r -= I_SQ;
    if (r < 4 * I_POOLG) { const int g = r / I_POOLG; r -= g * I_POOLG; const int kb = r / 4, nb = r % 4;
        return TrItem{p.in[I_POOL_W] + (size_t)g * 65536, 256, 256, (bf16_t*)(ws + W_POOL) + (size_t)g * 65536, nb * 64, nb * 64, kb * 64, nullptr, 1.f}; } r -= 4 * I_POOLG;
    if (r < I_SIN) { const int kb = r / 84, nb = r % 84; const int n0 = nb * 64;
        return TrItem{p.in[I_SSD_WIN], 1024, 5152, (bf16_t*)(ws + W_SSD_IN), n0, n0, kb * 64, p.in[I_MIXNW] + 2 * 1024, 1.f}; } r -= I_SIN;
    if (r < I_SOUT) { const int kb = r / 16, nb = r % 16;
        return TrItem{p.in[I_SSD_WOUT], 2048, 1024, (bf16_t*)(ws + W_SSD_OUT), nb * 64, nb * 64, kb * 64, p.in[I_SSD_NW], 1.f}; } r -= I_SOUT;
    if (r < I_QKV) { const int kb = r / 48, nb = r % 48; const int n0 = nb * 64;
        return TrItem{p.in[I_SB_WQKV], 1024, 3072, (bf16_t*)(ws + W_SB_QKV), n0, n0, kb * 64, p.in[I_MIXNW] + 3 * 1024, n0 < 1024 ? 0.125f * 1.4426950408889634f : 1.f}; } r -= I_QKV;
    { const int kb = r / 16, nb = r % 16;
        return TrItem{p.in[I_SB_WOUT], 1024, 1024, (bf16_t*)(ws + W_SB_OUT), nb * 64, nb * 64, kb * 64, nullptr, 1.f}; }
}

__device__ __forceinline__ void prep_phase(const Params& p, unsigned char* lds, int gw, int NGW, int wave, int lane) {
    float* scr = (float*)(lds + wave * 16640);
    unsigned char* ws = p.ws;
    for (int it = gw; it < NITEMS; it += 2 * NGW) {
        const TrItem ta = tr_desc(p, it); const bool hasb = (it + NGW) < NITEMS; const TrItem tb = tr_desc(p, hasb ? it + NGW : it);
        float va[64], vb[64];
        tr_load(ta, va, lane); if (hasb) tr_load(tb, vb, lane);
        tr_store(ta, va, scr, lane); if (hasb) tr_store(tb, vb, scr, lane);
    }
    const float* x = p.in[I_X]; bf16_t* XB = (bf16_t*)(ws + WS_XB); float* rssp = (float*)(ws + WS_RSSP);
    for (int m0 = gw * 4; m0 < NTOK; m0 += NGW * 4) {
        f32x4 v[4][4];
#pragma unroll
        for (int r = 0; r < 4; ++r)
#pragma unroll
            for (int j = 0; j < 4; ++j) v[r][j] = __builtin_nontemporal_load((const f32x4*)(x + (size_t)(m0 + r) * DM) + lane + 64 * j);
#pragma unroll
        for (int r = 0; r < 4; ++r) { float s = 0.f; unsigned long long* o8 = (unsigned long long*)(XB + (size_t)(m0 + r) * DM) + lane;
#pragma unroll
            for (int j = 0; j < 4; ++j) { const f32x4 t = v[r][j]; s += (t.x * t.x + t.y * t.y) + (t.z * t.z + t.w * t.w);
                o8[64 * j] = (unsigned long long)cvt_pk_bf16(t.x, t.y) | ((unsigned long long)cvt_pk_bf16(t.z, t.w) << 32); }
            s += __shfl_xor(s, 1); s += __shfl_xor(s, 2); s += __shfl_xor(s, 4); s += __shfl_xor(s, 8);
            if ((lane & 15) == 0) rssp[(size_t)(m0 + r) * 4 + (lane >> 4)] = s; }
    }
}

__device__ __forceinline__ void gla1_phase(const Params& p, unsigned char* lds, int bid, int G, int tid) {
    unsigned char* ws = p.ws;
    const bf16_t* P = (const bf16_t*)(ws + WS_BIG); const float* GLR = (const float*)(ws + WS_BIG + BIG_GLA_GLR);
    bf16_t* KDT = (bf16_t*)(ws + WS_BIG + BIG_GLA_KDT); float* EG = (float*)(ws + WS_BIG + BIG_GLA_EG); bf16_t* VT = (bf16_t*)p.out;
    float* glr_s = (float*)lds;
    float* wg_s = (float*)(lds + 4096);
    float* bg_s = (float*)(lds + 12288);
    float* tot_s = (float*)(lds + 12800);
    unsigned char* vt_s = lds + 16384;
    const float* wg2 = p.in[I_GLA_WG2]; const float* bgate = p.in[I_GLA_BG];
    for (int it = bid; it < 2048; it += G) {
        const int h = it & 3, c = (it >> 2) & 63, b = it >> 8; const int row0 = b * SEQL + c * 64;
        __syncthreads();
        for (int e = tid; e < 1024; e += 512) glr_s[e] = GLR[(size_t)(row0 + (e >> 4)) * 16 + (e & 15)];
        for (int e = tid; e < 2048; e += 512) wg_s[e] = wg2[(e >> 7) * 512 + h * 128 + (e & 127)];
        if (tid < 128) bg_s[tid] = bgate[h * 128 + tid];
        for (int e = tid; e < 2048; e += 512) { const int s = e >> 5, part = e & 31; *(u32x4*)(vt_s + s * 528 + part * 16) = __builtin_nontemporal_load((const u32x4*)(P + (size_t)(row0 + s) * 3072 + 1024 + h * 256 + part * 8)); }
        __syncthreads();
        const int k = tid & 127, sg = tid >> 7;
        float w[16];
#pragma unroll
        for (int j = 0; j < 16; ++j) w[j] = wg_s[j * 128 + k];
        const float bgk = bg_s[k];
        float gl[16]; float run = 0.f;
#pragma unroll
        for (int i = 0; i < 16; ++i) { const float* gr = glr_s + (sg * 16 + i) * 16; float pre = bgk;
#pragma unroll
            for (int j = 0; j < 16; ++j) pre += gr[j] * w[j];
            const float ls = fminf(pre, 0.f) - log1pf(expf(-fabsf(pre)));
            run += ls * (1.0f / 16.0f); gl[i] = run; }
        tot_s[sg * 128 + k] = run;
        __syncthreads();
        float off = 0.f, gend = 0.f;
#pragma unroll
        for (int g2 = 0; g2 < 4; ++g2) { const float tv = tot_s[g2 * 128 + k]; if (g2 < sg) off += tv; gend += tv; }
        unsigned pk[8];
#pragma unroll
        for (int i = 0; i < 16; i += 2) {
            const float k0 = bf1(P[(size_t)(row0 + sg * 16 + i) * 3072 + 512 + h * 128 + k]) * expf(gend - (off + gl[i]));
            const float k1 = bf1(P[(size_t)(row0 + sg * 16 + i + 1) * 3072 + 512 + h * 128 + k]) * expf(gend - (off + gl[i + 1]));
            pk[i >> 1] = cvt_pk_bf16(k0, k1); }
        u32x4* kd = (u32x4*)(KDT + (size_t)it * 8192 + k * 64 + sg * 16);
        kd[0] = (u32x4){pk[0], pk[1], pk[2], pk[3]}; kd[1] = (u32x4){pk[4], pk[5], pk[6], pk[7]};
        if (sg == 0) EG[(size_t)it * 128 + k] = expf(gend);
        { const int v = tid & 255, sh = tid >> 8; unsigned q[16];
#pragma unroll
            for (int i = 0; i < 16; ++i) { const unsigned lo = *(const bf16_t*)(vt_s + (sh * 32 + 2 * i) * 528 + v * 2), hi = *(const bf16_t*)(vt_s + (sh * 32 + 2 * i + 1) * 528 + v * 2); q[i] = lo | (hi << 16); }
            u32x4* vo = (u32x4*)(VT + (size_t)it * 16384 + v * 64 + sh * 32);
            vo[0] = (u32x4){q[0], q[1], q[2], q[3]}; vo[1] = (u32x4){q[4], q[5], q[6], q[7]}; vo[2] = (u32x4){q[8], q[9], q[10], q[11]}; vo[3] = (u32x4){q[12], q[13], q[14], q[15]}; }
    }
}

constexpr size_t BIG_GLA_SLOC = 292 * MiB, BIG_GLA_DSEG = 291 * MiB;
__device__ __forceinline__ void gla_scan_phase(const Params& p, unsigned char* lds, int bid, int G, int tid, int wave, int lane, const int MODE) {
    unsigned char* ws = p.ws;
    const bf16_t* P = (const bf16_t*)(ws + WS_BIG);
    const bf16_t* KDT = (const bf16_t*)(ws + WS_BIG + BIG_GLA_KDT); const float* EG = (const float*)(ws + WS_BIG + BIG_GLA_EG); const bf16_t* VT = (const bf16_t*)p.out;
    bf16_t* OPRE = (bf16_t*)(ws + WS_BIG + BIG_GLA_OPRE); float* SLOC = (float*)(ws + WS_BIG + BIG_GLA_SLOC); float* DSEG = (float*)(ws + WS_BIG + BIG_GLA_DSEG);
    unsigned char* KD = lds;
    unsigned char* VTs = lds + 18432;
    unsigned char* Qs = lds + 55296;
    unsigned char* ST = lds + 72704;
    float* eg_s = (float*)(lds + 142336);
    const int fr = lane & 15, fq = lane >> 4;
    for (int u = bid; u < 256; u += G) {
        const int seg = u & 7, bh = u >> 3, b = bh >> 2, h = bh & 3;
        if (MODE == 1 && seg == 7) continue;
        f32x4 S[16]; f32x4 dprod = (f32x4){1.f, 1.f, 1.f, 1.f};
        float* sl = SLOC + (size_t)u * 32768;
#pragma unroll
        for (int j = 0; j < 16; ++j) { if (MODE == 2) S[j] = *(const f32x4*)(sl + (16 * j + fr) * 128 + 16 * wave + 4 * fq); else S[j] = (f32x4){0.f, 0.f, 0.f, 0.f}; }
        u32x4 pk[2], pv[4], pq[2]; float peg = 0.f;
#define GLA_LOAD(cc) do { const int it_ = (b * 64 + (cc)) * 4 + h; const int r0_ = b * SEQL + (cc) * 64; \
            _Pragma("unroll") for (int i_ = 0; i_ < 2; ++i_) pk[i_] = *(const u32x4*)(KDT + (size_t)it_ * 8192 + (tid + 512 * i_) * 8); \
            _Pragma("unroll") for (int i_ = 0; i_ < 4; ++i_) pv[i_] = *(const u32x4*)(VT + (size_t)it_ * 16384 + (tid + 512 * i_) * 8); \
            if (MODE == 2) { _Pragma("unroll") for (int i_ = 0; i_ < 2; ++i_) { const int e_ = tid + 512 * i_; pq[i_] = *(const u32x4*)(P + (size_t)(r0_ + (e_ >> 4)) * 3072 + h * 128 + (e_ & 15) * 8); } } \
            if (tid < 128) peg = EG[(size_t)it_ * 128 + tid]; } while (0)
        GLA_LOAD(seg * 8);
        for (int c = seg * 8; c < seg * 8 + 8; ++c) {
            const int row0 = b * SEQL + c * 64;
            LBAR();
#pragma unroll
            for (int i = 0; i < 2; ++i) { const int e = tid + 512 * i; *(u32x4*)(KD + (e >> 3) * 144 + (e & 7) * 16) = pk[i]; }
#pragma unroll
            for (int i = 0; i < 4; ++i) { const int e = tid + 512 * i; *(u32x4*)(VTs + (e >> 3) * 144 + (e & 7) * 16) = pv[i]; }
            if (MODE == 2) {
#pragma unroll
                for (int i = 0; i < 2; ++i) { const int e = tid + 512 * i; *(u32x4*)(Qs + (e >> 4) * 272 + (e & 15) * 16) = pq[i]; } }
            if (tid < 128) eg_s[tid] = peg;
            if (c + 1 < seg * 8 + 8) GLA_LOAD(c + 1);
            LBAR();
            { const f32x4 ev = *(const f32x4*)(eg_s + 16 * wave + 4 * fq); dprod = dprod * ev;
              const bf16x8 a0 = ldsfrag(KD + (16 * wave + fr) * 144 + fq * 16), a1 = ldsfrag(KD + (16 * wave + fr) * 144 + 64 + fq * 16);
#pragma unroll
              for (int j4 = 0; j4 < 16; j4 += 4) { bf16x8 vb0[4], vb1[4];
#pragma unroll
                  for (int jj = 0; jj < 4; ++jj) { vb0[jj] = ldsfrag(VTs + (16 * (j4 + jj) + fr) * 144 + fq * 16); vb1[jj] = ldsfrag(VTs + (16 * (j4 + jj) + fr) * 144 + 64 + fq * 16); }
#pragma unroll
                  for (int jj = 0; jj < 4; ++jj) S[j4 + jj] = S[j4 + jj] * ev;
#pragma unroll
                  for (int jj = 0; jj < 4; ++jj) S[j4 + jj] = MFMA16(a0, vb0[jj], S[j4 + jj]);
#pragma unroll
                  for (int jj = 0; jj < 4; ++jj) S[j4 + jj] = MFMA16(a1, vb1[jj], S[j4 + jj]);
                  if (MODE == 2) {
#pragma unroll
                      for (int jj = 0; jj < 4; ++jj) { const int j = j4 + jj; u32x2 w; w.x = cvt_pk_bf16(S[j][0], S[j][1]); w.y = cvt_pk_bf16(S[j][2], S[j][3]);
                          *(u32x2*)(ST + (16 * j + fr) * 272 + (16 * wave + 4 * fq) * 2) = w; } } } }
            if (MODE == 2) {
            LBAR();
            f32x4 o[2][4];
#pragma unroll
            for (int jj = 0; jj < 2; ++jj)
#pragma unroll
                for (int tt = 0; tt < 4; ++tt) o[jj][tt] = (f32x4){0.f, 0.f, 0.f, 0.f};
#pragma unroll
            for (int ks = 0; ks < 4; ++ks) {
                bf16x8 av[2], bq[4];
#pragma unroll
                for (int jj = 0; jj < 2; ++jj) av[jj] = ldsfrag(ST + (16 * (2 * wave + jj) + fr) * 272 + ks * 64 + fq * 16);
#pragma unroll
                for (int tt = 0; tt < 4; ++tt) bq[tt] = ldsfrag(Qs + (16 * tt + fr) * 272 + ks * 64 + fq * 16);
#pragma unroll
                for (int jj = 0; jj < 2; ++jj)
#pragma unroll
                    for (int tt = 0; tt < 4; ++tt) o[jj][tt] = MFMA16(av[jj], bq[tt], o[jj][tt]);
            }
#pragma unroll
            for (int jj = 0; jj < 2; ++jj)
#pragma unroll
                for (int tt = 0; tt < 4; ++tt) { u32x2 w; w.x = cvt_pk_bf16(o[jj][tt][0], o[jj][tt][1]); w.y = cvt_pk_bf16(o[jj][tt][2], o[jj][tt][3]);
                    *(u32x2*)(OPRE + (size_t)(row0 + 16 * tt + fr) * DM + h * 256 + 16 * (2 * wave + jj) + 4 * fq) = w; }
            }
        }
        if (MODE == 1) {
#pragma unroll
            for (int j = 0; j < 16; ++j) *(f32x4*)(sl + (16 * j + fr) * 128 + 16 * wave + 4 * fq) = S[j];
            if (fr == 0) *(f32x4*)(DSEG + (size_t)u * 128 + 16 * wave + 4 * fq) = dprod;
        }
    }
#undef GLA_LOAD
}
__device__ __forceinline__ void gla_combine_phase(const Params& p, int bid, int G, int tid) {
    float* SLOC = (float*)(p.ws + WS_BIG + BIG_GLA_SLOC); const float* DSEG = (const float*)(p.ws + WS_BIG + BIG_GLA_DSEG);
    for (int idx = bid * 512 + tid; idx < 32 * 8192; idx += G * 512) { const int bh = idx >> 13, e = (idx & 8191) * 4, k0 = e & 127;
        f32x4 prev = (f32x4){0.f, 0.f, 0.f, 0.f};
#pragma unroll
        for (int seg = 0; seg < 8; ++seg) { const int u = bh * 8 + seg; f32x4* q = (f32x4*)(SLOC + (size_t)u * 32768 + e);
            f32x4 loc = (f32x4){0.f, 0.f, 0.f, 0.f}, d = (f32x4){0.f, 0.f, 0.f, 0.f};
            if (seg < 7) { loc = *q; d = *(const f32x4*)(DSEG + (size_t)u * 128 + k0); }
            *q = prev; prev = loc + d * prev; } }
}

__device__ __forceinline__ void gla3_phase(const Params& p, int gw, int NGW, int lane) {
    unsigned char* ws = p.ws;
    const bf16_t* P = (const bf16_t*)(ws + WS_BIG); bf16_t* OPRE = (bf16_t*)(ws + WS_BIG + BIG_GLA_OPRE);
    const float* nw = p.in[I_GLA_NW] + 16 * lane;
    float nwv[16];
#pragma unroll
    for (int i = 0; i < 16; ++i) nwv[i] = nw[i];
    for (int m = gw; m < NTOK; m += NGW) {
        u32x4* op = (u32x4*)(OPRE + (size_t)m * DM + 16 * lane); const u32x4* rp = (const u32x4*)(P + (size_t)m * 3072 + 2048 + 16 * lane);
        const u32x4 o0 = op[0], o1 = op[1], r0 = rp[0], r1 = rp[1];
        float ov[16], rv[16];
#pragma unroll
        for (int i = 0; i < 4; ++i) { ov[2 * i] = bflo(o0[i]); ov[2 * i + 1] = bfhi(o0[i]); ov[8 + 2 * i] = bflo(o1[i]); ov[8 + 2 * i + 1] = bfhi(o1[i]);
            rv[2 * i] = bflo(r0[i]); rv[2 * i + 1] = bfhi(r0[i]); rv[8 + 2 * i] = bflo(r1[i]); rv[8 + 2 * i + 1] = bfhi(r1[i]); }
        float ss = 0.f;
#pragma unroll
        for (int i = 0; i < 16; ++i) ss += ov[i] * ov[i];
        ss += __shfl_xor(ss, 1); ss += __shfl_xor(ss, 2); ss += __shfl_xor(ss, 4); ss += __shfl_xor(ss, 8);
        const float rstd = rsqrtf(ss * (1.0f / 256.0f) + 1e-6f);
        float res[16];
#pragma unroll
        for (int i = 0; i < 16; ++i) res[i] = ov[i] * rstd * nwv[i] * fast_silu(rv[i]);
        u32x4 w0, w1;
#pragma unroll
        for (int i = 0; i < 4; ++i) { w0[i] = cvt_pk_bf16(res[2 * i], res[2 * i + 1]); w1[i] = cvt_pk_bf16(res[8 + 2 * i], res[8 + 2 * i + 1]); }
        op[0] = w0; op[1] = w1;
    }
}

__device__ __forceinline__ void pool_dlt_phase(const Params& p, unsigned char* lds, int bid, int G, int tid) {
    unsigned char* ws = p.ws;
    const bf16_t* X = (const bf16_t*)(ws + WS_XB); const float* rssp = (const float*)(ws + WS_RSSP); bf16_t* DLT = (bf16_t*)(ws + WS_BIG);
    float* rs_s = (float*)lds;
    const int c = 2 * tid; const int win = 2 << (c >> 8);
    const float w0 = p.in[I_MIXNW][1024 + c], w1 = p.in[I_MIXNW][1024 + c + 1];
    for (int u = bid; u < 512; u += G) {
        const int b = u >> 6, t0 = (u & 63) * 64;
        __syncthreads();
        if (tid < 79) { const int j = t0 - 15 + tid; rs_s[tid] = j >= 0 ? row_rstd(rssp, b * SEQL + j) : 0.f; }
        __syncthreads();
        float s0 = 0.f, s1 = 0.f;
        for (int j = t0 - win + 1; j < t0; ++j) if (j >= 0) { const unsigned xv = *(const unsigned*)(X + (size_t)(b * SEQL + j) * DM + c); const float r = rs_s[j - t0 + 15]; s0 += bflo(xv) * r * w0; s1 += bfhi(xv) * r * w1; }
#pragma unroll 8
        for (int t = t0; t < t0 + 64; ++t) {
            const unsigned xv = *(const unsigned*)(X + (size_t)(b * SEQL + t) * DM + c); const float r = rs_s[t - t0 + 15];
            const float h0 = bflo(xv) * r * w0, h1 = bfhi(xv) * r * w1; s0 += h0; s1 += h1;
            const float inv = 1.0f / (float)min(t + 1, win);
            *(unsigned*)(DLT + (size_t)(b * SEQL + t) * DM + c) = cvt_pk_bf16(s0 * inv - h0, s1 * inv - h1);
            const int jo = t - win + 1;
            if (jo >= 0) { const unsigned xo = *(const unsigned*)(X + (size_t)(b * SEQL + jo) * DM + c); const float ro = rs_s[jo - t0 + 15]; s0 -= bflo(xo) * ro * w0; s1 -= bfhi(xo) * ro * w1; }
        }
    }
}

__device__ __forceinline__ float softplusf(float x) { return fmaxf(x, 0.f) + log1pf(expf(-fabsf(x))); }
constexpr size_t XBR_ACS = 0, XBR_HALO = 8 * MiB;
__device__ __forceinline__ void ssd_dt_fix_phase(const Params& p, unsigned char* lds, int bid, int G, int tid) {
    bf16_t* P = (bf16_t*)(p.ws + WS_BIG); float* DT = (float*)(p.ws + WS_BIG + BIG_SSD_DT); float* ACS = (float*)((unsigned char*)p.out + XBR_ACS);
    const float* side = (const float*)((unsigned char*)p.out + XBR_HALO);
    const float* cw = p.in[I_SSD_CW]; const float* cb = p.in[I_SSD_CB];
    float* tot_s = (float*)lds;
    for (int u = bid; u < 512; u += G) { const int b = u >> 6, c = u & 63; const int row0 = b * SEQL + c * 64;
        const int h = tid & 31, sg = tid >> 5; const float dtb = p.in[I_SSD_DTB][h], aneg = -expf(p.in[I_SSD_ALOG][h]);
        float dtv[4], ac[4]; float run = 0.f;
#pragma unroll
        for (int i = 0; i < 4; ++i) { dtv[i] = softplusf(DT[(size_t)(row0 + 4 * sg + i) * 32 + h] + dtb); run += dtv[i] * aneg; ac[i] = run; }
        __syncthreads(); tot_s[sg * 32 + h] = run; __syncthreads();
        float off = 0.f;
        for (int g2 = 0; g2 < sg; ++g2) off += tot_s[g2 * 32 + h];
#pragma unroll
        for (int i = 0; i < 4; ++i) { DT[(size_t)(row0 + 4 * sg + i) * 32 + h] = dtv[i]; ACS[(size_t)(row0 + 4 * sg + i) * 32 + h] = off + ac[i]; }
    }
    for (int idx = bid * 512 + tid; idx < 128 * 3 * 768; idx += G * 512) {
        const int q = idx % 768, r = idx / 768, tau = r % 3, pm = r / 3;
        if ((pm & 15) == 0) continue;
        const int xc = q * 4;
        const float* cur = side + (size_t)pm * 6 * 3072 + xc; const float* prv = side + (size_t)(pm - 1) * 6 * 3072 + xc;
        const f32x4 u0 = *(const f32x4*)(cur + tau * 3072);
        const f32x4 u1 = tau >= 1 ? *(const f32x4*)(cur + (tau - 1) * 3072) : *(const f32x4*)(prv + 5 * 3072);
        const f32x4 u2 = tau >= 2 ? *(const f32x4*)(cur + (tau - 2) * 3072) : *(const f32x4*)(prv + (4 + tau) * 3072);
        const f32x4 u3 = *(const f32x4*)(prv + (3 + tau) * 3072);
        const f32x4 o = *(const f32x4*)(cb + xc) + *(const f32x4*)(cw + 3 * 3072 + xc) * u0 + *(const f32x4*)(cw + 2 * 3072 + xc) * u1 + *(const f32x4*)(cw + 3072 + xc) * u2 + *(const f32x4*)(cw + xc) * u3;
        u32x2 w; w.x = cvt_pk_bf16(fast_silu(o[0]), fast_silu(o[1])); w.y = cvt_pk_bf16(fast_silu(o[2]), fast_silu(o[3]));
        *(u32x2*)(P + (size_t)(pm * 256 + tau) * 5120 + 2048 + xc) = w;
    }
}
__device__ __forceinline__ void ssd_scan_phase(const Params& p, unsigned char* lds, int bid, int G, int tid, int wave, int lane, int dry) {
    unsigned char* ws = p.ws;
    bf16_t* P = (bf16_t*)(ws + WS_BIG); const float* DT = (const float*)(ws + WS_BIG + BIG_SSD_DT); const float* ACS = (const float*)((unsigned char*)p.out + XBR_ACS);
    unsigned char* Cm = lds;
    unsigned char* Bm = lds + 17408;
    unsigned char* BdT = lds + 34816;
    unsigned char* xdtT = lds + 53248;
    unsigned char* xT = lds + 62464;
    unsigned char* Mt = lds + 71680;
    unsigned char* stB = lds + 80896;
    float* acs_s = (float*)(lds + 115712);
    const int fr = lane & 15, fq = lane >> 4;
    for (int u = bid; u < 256; u += G) {
        const int b = u >> 5, h = u & 31, g = h >> 3;
        const float dsk = p.in[I_SSD_D][h];
        f32x4 st[4];
#pragma unroll
        for (int i = 0; i < 4; ++i) st[i] = (f32x4){0.f, 0.f, 0.f, 0.f};
        LBAR();
        for (int e = tid; e < 64 * 272 / 4; e += 512) ((unsigned*)stB)[e] = 0u;
        const int sx = tid >> 3, partx = tid & 7;
        u32x4 pxA, pbA[2], pcA[2], pxB, pbB[2], pcB[2]; float pdtA, pacsbA[2], pacs_endA, pacs_tA = 0.f, pdtB, pacsbB[2], pacs_endB, pacs_tB = 0.f;
#define SSD_LOAD(S_, cc) do { const int r0_ = b * SEQL + (cc) * 64; \
            px##S_ = *(const u32x4*)(P + (size_t)(r0_ + sx) * 5120 + 2048 + h * 64 + partx * 8); pdt##S_ = DT[(size_t)(r0_ + sx) * 32 + h]; \
            _Pragma("unroll") for (int i_ = 0; i_ < 2; ++i_) { const int e_ = tid + 512 * i_; const int sb_ = e_ >> 4, pt_ = e_ & 15; \
                pb##S_[i_] = *(const u32x4*)(P + (size_t)(r0_ + sb_) * 5120 + 4096 + g * 128 + pt_ * 8); pc##S_[i_] = *(const u32x4*)(P + (size_t)(r0_ + sb_) * 5120 + 4608 + g * 128 + pt_ * 8); \
                pacsb##S_[i_] = ACS[(size_t)(r0_ + sb_) * 32 + h]; } \
            pacs_end##S_ = ACS[(size_t)(r0_ + 63) * 32 + h]; if (tid < 64) pacs_t##S_ = ACS[(size_t)(r0_ + tid) * 32 + h]; } while (0)
        SSD_LOAD(A, 0); SSD_LOAD(B, 1);
        for (int c0 = 0; c0 < 64; c0 += 2) {
          { const int c = c0;
            const int row0 = b * SEQL + c * 64;
            LBAR();
            const float acs_end = pacs_endA;
            {
#pragma unroll
                for (int j = 0; j < 4; ++j) { const unsigned w = pxA[j]; const float x0 = bflo(w), x1 = bfhi(w);
                    *(bf16_t*)(xT + swz144(partx * 8 + 2 * j, sx * 2)) = (bf16_t)(w & 0xffffu); *(bf16_t*)(xT + swz144(partx * 8 + 2 * j + 1, sx * 2)) = (bf16_t)(w >> 16);
                    const unsigned d = cvt_pk_bf16(x0 * pdtA, x1 * pdtA);
                    *(bf16_t*)(xdtT + swz144(partx * 8 + 2 * j, sx * 2)) = (bf16_t)(d & 0xffffu); *(bf16_t*)(xdtT + swz144(partx * 8 + 2 * j + 1, sx * 2)) = (bf16_t)(d >> 16); }
#pragma unroll
                for (int i = 0; i < 2; ++i) { const int e = tid + 512 * i; const int sb = e >> 4, pt = e & 15;
                    *(u32x4*)(Bm + sb * 272 + pt * 16) = pbA[i]; *(u32x4*)(Cm + sb * 272 + pt * 16) = pcA[i];
                    const float dec = __expf(acs_end - pacsbA[i]);
#pragma unroll
                    for (int j = 0; j < 4; ++j) { const unsigned w = pbA[i][j]; const unsigned d = cvt_pk_bf16(bflo(w) * dec, bfhi(w) * dec);
                        *(bf16_t*)(BdT + swz144(pt * 8 + 2 * j, sb * 2)) = (bf16_t)(d & 0xffffu); *(bf16_t*)(BdT + swz144(pt * 8 + 2 * j + 1, sb * 2)) = (bf16_t)(d >> 16); } }
                if (tid < 64) acs_s[tid] = pacs_tA;
            }
            if (c + 2 < 64) SSD_LOAD(A, c + 2);
            LBAR();
            bf16x8 c0[4], c1[4];
            { const int stl = wave >> 1; const int tt0 = (wave & 1) * 2;
              bf16x8 a[4];
#pragma unroll
              for (int ks = 0; ks < 4; ++ks) { a[ks] = ldsfrag(Bm + (16 * stl + fr) * 272 + ks * 64 + fq * 16); c0[ks] = ldsfrag(Cm + (16 * tt0 + fr) * 272 + ks * 64 + fq * 16); c1[ks] = ldsfrag(Cm + (16 * (tt0 + 1) + fr) * 272 + ks * 64 + fq * 16); }
              const f32x4 as4 = *(const f32x4*)(acs_s + 16 * stl + 4 * fq); const float at0 = acs_s[16 * tt0 + fr], at1 = acs_s[16 * tt0 + 16 + fr];
              f32x4 d0 = (f32x4){0.f, 0.f, 0.f, 0.f}, d1 = d0;
#pragma unroll
              for (int ks = 0; ks < 4; ++ks) { d0 = MFMA16(a[ks], c0[ks], d0); d1 = MFMA16(a[ks], c1[ks], d1); }
#pragma unroll
              for (int tj = 0; tj < 2; ++tj) { const int t = 16 * (tt0 + tj) + fr; const float at = tj ? at1 : at0; const f32x4 d = tj ? d1 : d0; float mv[4];
#pragma unroll
                  for (int i = 0; i < 4; ++i) { const int sidx = 16 * stl + 4 * fq + i; const float e = __expf(fminf(at - as4[i], 0.f)); mv[i] = (sidx <= t) ? d[i] * e : 0.f; }
                  u32x2 w; w.x = cvt_pk_bf16(mv[0], mv[1]); w.y = cvt_pk_bf16(mv[2], mv[3]);
                  *(u32x2*)(Mt + t * 144 + (16 * stl + 4 * fq) * 2) = w; } }
            { const float ee = __expf(acs_end);
              const bf16x8 a0 = ldsfrag(BdT + swz144(16 * wave + fr, fq * 16)), a1 = ldsfrag(BdT + swz144(16 * wave + fr, 64 + fq * 16));
              bf16x8 xb0[4], xb1[4];
#pragma unroll
              for (int pt = 0; pt < 4; ++pt) { xb0[pt] = ldsfrag(xdtT + swz144(16 * pt + fr, fq * 16)); xb1[pt] = ldsfrag(xdtT + swz144(16 * pt + fr, 64 + fq * 16)); }
#pragma unroll
              for (int pt = 0; pt < 4; ++pt) st[pt] = st[pt] * ee;
#pragma unroll
              for (int pt = 0; pt < 4; ++pt) st[pt] = MFMA16(a0, xb0[pt], st[pt]);
#pragma unroll
              for (int pt = 0; pt < 4; ++pt) st[pt] = MFMA16(a1, xb1[pt], st[pt]);
#pragma unroll
              for (int pt = 0; pt < 4; ++pt) { u32x2 w; w.x = cvt_pk_bf16(st[pt][0], st[pt][1]); w.y = cvt_pk_bf16(st[pt][2], st[pt][3]);
                  *(u32x2*)(stB + ((c + 1) & 1) * 17408 + (16 * pt + fr) * 272 + (16 * wave + 4 * fq) * 2) = w; } }
            LBAR();
            { const int pt = wave >> 1; const int tt0 = (wave & 1) * 2;
              bf16x8 ax[2], as_[4], m0[2], m1[2];
#pragma unroll
              for (int ks = 0; ks < 2; ++ks) { ax[ks] = ldsfrag(xdtT + swz144(16 * pt + fr, ks * 64 + fq * 16)); m0[ks] = ldsfrag(Mt + (16 * tt0 + fr) * 144 + ks * 64 + fq * 16); m1[ks] = ldsfrag(Mt + (16 * tt0 + 16 + fr) * 144 + ks * 64 + fq * 16); }
#pragma unroll
              for (int ks = 0; ks < 4; ++ks) as_[ks] = ldsfrag(stB + (c & 1) * 17408 + (16 * pt + fr) * 272 + ks * 64 + fq * 16);
              const float ea0 = __expf(acs_s[16 * tt0 + fr]), ea1 = __expf(acs_s[16 * tt0 + 16 + fr]);
              float xs0[4], xs1[4];
#pragma unroll
              for (int i = 0; i < 4; ++i) { const int pp = 16 * pt + 4 * fq + i; xs0[i] = bf1(*(const bf16_t*)(xT + swz144(pp, (16 * tt0 + fr) * 2))); xs1[i] = bf1(*(const bf16_t*)(xT + swz144(pp, (16 * tt0 + 16 + fr) * 2))); }
              f32x4 yi0 = (f32x4){0.f, 0.f, 0.f, 0.f}, yi1 = yi0, ys0 = yi0, ys1 = yi0;
#pragma unroll
              for (int ks = 0; ks < 2; ++ks) { yi0 = MFMA16(ax[ks], m0[ks], yi0); yi1 = MFMA16(ax[ks], m1[ks], yi1); }
#pragma unroll
              for (int ks = 0; ks < 4; ++ks) { ys0 = MFMA16(as_[ks], c0[ks], ys0); ys1 = MFMA16(as_[ks], c1[ks], ys1); }
              u32x2 w0, w1;
              w0.x = cvt_pk_bf16(yi0[0] + ea0 * ys0[0] + dsk * xs0[0], yi0[1] + ea0 * ys0[1] + dsk * xs0[1]); w0.y = cvt_pk_bf16(yi0[2] + ea0 * ys0[2] + dsk * xs0[2], yi0[3] + ea0 * ys0[3] + dsk * xs0[3]);
              w1.x = cvt_pk_bf16(yi1[0] + ea1 * ys1[0] + dsk * xs1[0], yi1[1] + ea1 * ys1[1] + dsk * xs1[1]); w1.y = cvt_pk_bf16(yi1[2] + ea1 * ys1[2] + dsk * xs1[2], yi1[3] + ea1 * ys1[3] + dsk * xs1[3]);
              if (!dry) { *(u32x2*)(P + (size_t)(row0 + 16 * tt0 + fr) * 5120 + 2048 + h * 64 + 16 * pt + 4 * fq) = w0; *(u32x2*)(P + (size_t)(row0 + 16 * tt0 + 16 + fr) * 5120 + 2048 + h * 64 + 16 * pt + 4 * fq) = w1; } }
          }
          { const int c = c0 + 1;
            const int row0 = b * SEQL + c * 64;
            LBAR();
            const float acs_end = pacs_endB;
            {
#pragma unroll
                for (int j = 0; j < 4; ++j) { const unsigned w = pxB[j]; const float x0 = bflo(w), x1 = bfhi(w);
                    *(bf16_t*)(xT + swz144(partx * 8 + 2 * j, sx * 2)) = (bf16_t)(w & 0xffffu); *(bf16_t*)(xT + swz144(partx * 8 + 2 * j + 1, sx * 2)) = (bf16_t)(w >> 16);
                    const unsigned d = cvt_pk_bf16(x0 * pdtB, x1 * pdtB);
                    *(bf16_t*)(xdtT + swz144(partx * 8 + 2 * j, sx * 2)) = (bf16_t)(d & 0xffffu); *(bf16_t*)(xdtT + swz144(partx * 8 + 2 * j + 1, sx * 2)) = (bf16_t)(d >> 16); }
#pragma unroll
                for (int i = 0; i < 2; ++i) { const int e = tid + 512 * i; const int sb = e >> 4, pt = e & 15;
                    *(u32x4*)(Bm + sb * 272 + pt * 16) = pbB[i]; *(u32x4*)(Cm + sb * 272 + pt * 16) = pcB[i];
                    const float dec = __expf(acs_end - pacsbB[i]);
#pragma unroll
                    for (int j = 0; j < 4; ++j) { const unsigned w = pbB[i][j]; const unsigned d = cvt_pk_bf16(bflo(w) * dec, bfhi(w) * dec);
                        *(bf16_t*)(BdT + swz144(pt * 8 + 2 * j, sb * 2)) = (bf16_t)(d & 0xffffu); *(bf16_t*)(BdT + swz144(pt * 8 + 2 * j + 1, sb * 2)) = (bf16_t)(d >> 16); } }
                if (tid < 64) acs_s[tid] = pacs_tB;
            }
            if (c + 2 < 64) SSD_LOAD(B, c + 2);
            LBAR();
            bf16x8 c0[4], c1[4];
            { const int stl = wave >> 1; const int tt0 = (wave & 1) * 2;
              bf16x8 a[4];
#pragma unroll
              for (int ks = 0; ks < 4; ++ks) { a[ks] = ldsfrag(Bm + (16 * stl + fr) * 272 + ks * 64 + fq * 16); c0[ks] = ldsfrag(Cm + (16 * tt0 + fr) * 272 + ks * 64 + fq * 16); c1[ks] = ldsfrag(Cm + (16 * (tt0 + 1) + fr) * 272 + ks * 64 + fq * 16); }
              const f32x4 as4 = *(const f32x4*)(acs_s + 16 * stl + 4 * fq); const float at0 = acs_s[16 * tt0 + fr], at1 = acs_s[16 * tt0 + 16 + fr];
              f32x4 d0 = (f32x4){0.f, 0.f, 0.f, 0.f}, d1 = d0;
#pragma unroll
              for (int ks = 0; ks < 4; ++ks) { d0 = MFMA16(a[ks], c0[ks], d0); d1 = MFMA16(a[ks], c1[ks], d1); }
#pragma unroll
              for (int tj = 0; tj < 2; ++tj) { const int t = 16 * (tt0 + tj) + fr; const float at = tj ? at1 : at0; const f32x4 d = tj ? d1 : d0; float mv[4];
#pragma unroll
                  for (int i = 0; i < 4; ++i) { const int sidx = 16 * stl + 4 * fq + i; const float e = __expf(fminf(at - as4[i], 0.f)); mv[i] = (sidx <= t) ? d[i] * e : 0.f; }
                  u32x2 w; w.x = cvt_pk_bf16(mv[0], mv[1]); w.y = cvt_pk_bf16(mv[2], mv[3]);
                  *(u32x2*)(Mt + t * 144 + (16 * stl + 4 * fq) * 2) = w; } }
            { const float ee = __expf(acs_end);
              const bf16x8 a0 = ldsfrag(BdT + swz144(16 * wave + fr, fq * 16)), a1 = ldsfrag(BdT + swz144(16 * wave + fr, 64 + fq * 16));
              bf16x8 xb0[4], xb1[4];
#pragma unroll
              for (int pt = 0; pt < 4; ++pt) { xb0[pt] = ldsfrag(xdtT + swz144(16 * pt + fr, fq * 16)); xb1[pt] = ldsfrag(xdtT + swz144(16 * pt + fr, 64 + fq * 16)); }
#pragma unroll
              for (int pt = 0; pt < 4; ++pt) st[pt] = st[pt] * ee;
#pragma unroll
              for (int pt = 0; pt < 4; ++pt) st[pt] = MFMA16(a0, xb0[pt], st[pt]);
#pragma unroll
              for (int pt = 0; pt < 4; ++pt) st[pt] = MFMA16(a1, xb1[pt], st[pt]);
#pragma unroll
              for (int pt = 0; pt < 4; ++pt) { u32x2 w; w.x = cvt_pk_bf16(st[pt][0], st[pt][1]); w.y = cvt_pk_bf16(st[pt][2], st[pt][3]);
                  *(u32x2*)(stB + ((c + 1) & 1) * 17408 + (16 * pt + fr) * 272 + (16 * wave + 4 * fq) * 2) = w; } }
            LBAR();
            { const int pt = wave >> 1; const int tt0 = (wave & 1) * 2;
              bf16x8 ax[2], as_[4], m0[2], m1[2];
#pragma unroll
              for (int ks = 0; ks < 2; ++ks) { ax[ks] = ldsfrag(xdtT + swz144(16 * pt + fr, ks * 64 + fq * 16)); m0[ks] = ldsfrag(Mt + (16 * tt0 + fr) * 144 + ks * 64 + fq * 16); m1[ks] = ldsfrag(Mt + (16 * tt0 + 16 + fr) * 144 + ks * 64 + fq * 16); }
#pragma unroll
              for (int ks = 0; ks < 4; ++ks) as_[ks] = ldsfrag(stB + (c & 1) * 17408 + (16 * pt + fr) * 272 + ks * 64 + fq * 16);
              const float ea0 = __expf(acs_s[16 * tt0 + fr]), ea1 = __expf(acs_s[16 * tt0 + 16 + fr]);
              float xs0[4], xs1[4];
#pragma unroll
              for (int i = 0; i < 4; ++i) { const int pp = 16 * pt + 4 * fq + i; xs0[i] = bf1(*(const bf16_t*)(xT + swz144(pp, (16 * tt0 + fr) * 2))); xs1[i] = bf1(*(const bf16_t*)(xT + swz144(pp, (16 * tt0 + 16 + fr) * 2))); }
              f32x4 yi0 = (f32x4){0.f, 0.f, 0.f, 0.f}, yi1 = yi0, ys0 = yi0, ys1 = yi0;
#pragma unroll
              for (int ks = 0; ks < 2; ++ks) { yi0 = MFMA16(ax[ks], m0[ks], yi0); yi1 = MFMA16(ax[ks], m1[ks], yi1); }
#pragma unroll
              for (int ks = 0; ks < 4; ++ks) { ys0 = MFMA16(as_[ks], c0[ks], ys0); ys1 = MFMA16(as_[ks], c1[ks], ys1); }
              u32x2 w0, w1;
              w0.x = cvt_pk_bf16(yi0[0] + ea0 * ys0[0] + dsk * xs0[0], yi0[1] + ea0 * ys0[1] + dsk * xs0[1]); w0.y = cvt_pk_bf16(yi0[2] + ea0 * ys0[2] + dsk * xs0[2], yi0[3] + ea0 * ys0[3] + dsk * xs0[3]);
              w1.x = cvt_pk_bf16(yi1[0] + ea1 * ys1[0] + dsk * xs1[0], yi1[1] + ea1 * ys1[1] + dsk * xs1[1]); w1.y = cvt_pk_bf16(yi1[2] + ea1 * ys1[2] + dsk * xs1[2], yi1[3] + ea1 * ys1[3] + dsk * xs1[3]);
              if (!dry) { *(u32x2*)(P + (size_t)(row0 + 16 * tt0 + fr) * 5120 + 2048 + h * 64 + 16 * pt + 4 * fq) = w0; *(u32x2*)(P + (size_t)(row0 + 16 * tt0 + 16 + fr) * 5120 + 2048 + h * 64 + 16 * pt + 4 * fq) = w1; } }
          }
        }
    }
}

__device__ __forceinline__ void ssd3_phase(const Params& p, int gw, int NGW, int lane) {
    bf16_t* P = (bf16_t*)(p.ws + WS_BIG);
    for (int m = gw; m < NTOK; m += NGW) {
        u32x4* yp = (u32x4*)(P + (size_t)m * 5120 + 2048 + 32 * lane); const u32x4* zp = (const u32x4*)(P + (size_t)m * 5120 + 32 * lane);
        float v[32]; float ss = 0.f;
#pragma unroll
        for (int q = 0; q < 4; ++q) { const u32x4 y = yp[q], z = zp[q];
#pragma unroll
            for (int i = 0; i < 4; ++i) { const float a = bflo(y[i]) * fast_silu(bflo(z[i])), c = bfhi(y[i]) * fast_silu(bfhi(z[i])); v[8 * q + 2 * i] = a; v[8 * q + 2 * i + 1] = c; ss += a * a + c * c; } }
        ss += __shfl_xor(ss, 1); ss += __shfl_xor(ss, 2); ss += __shfl_xor(ss, 4); ss += __shfl_xor(ss, 8);
        const float rstd = rsqrtf(ss * (1.0f / 512.0f) + 1e-6f);
#pragma unroll
        for (int q = 0; q < 4; ++q) { u32x4 w;
#pragma unroll
            for (int i = 0; i < 4; ++i) w[i] = cvt_pk_bf16(v[8 * q + 2 * i] * rstd, v[8 * q + 2 * i + 1] * rstd);
            yp[q] = w; }
    }
}

__device__ __forceinline__ void sb_attn_phase(const Params& p, unsigned char* lds, int bid, int G, int tid, int wave, int lane) {
    unsigned char* ws = p.ws;
    const bf16_t* P = (const bf16_t*)(ws + WS_BIG); bf16_t* AO = (bf16_t*)(ws + WS_BIG + BIG_SB_AO);
    unsigned char* Ks = lds;
    unsigned char* VTs = lds + 9216;
    int* flags = (int*)(lds + 18432);
    const int fr = lane & 15, fq = lane >> 4;
    bf16x8 U[4][2], ones;
#pragma unroll
    for (int jj = 0; jj < 8; ++jj) ones[jj] = (short)0x3F80;
#pragma unroll
    for (int io = 0; io < 4; ++io)
#pragma unroll
        for (int ks = 0; ks < 2; ++ks)
#pragma unroll
            for (int jj = 0; jj < 8; ++jj) { const int kj = 32 * ks + (jj < 4 ? 4 * fq + jj : 16 + 4 * fq + (jj - 4)); U[io][ks][jj] = (kj > 16 * io + fr) ? (short)0x3F80 : (short)0; }
    const int ss_ = tid >> 3, part_ = tid & 7; u32x4 pkkA, pvvA, pkkB, pvvB;
#define SB_LOAD(S_, b_, h_, kt_) do { const size_t krow_ = (size_t)((b_) * SEQL + 64 * (kt_) + ss_) * 3072; pkk##S_ = *(const u32x4*)(P + krow_ + 1024 + (h_) * 64 + part_ * 8); pvv##S_ = *(const u32x4*)(P + krow_ + 2048 + (h_) * 64 + part_ * 8); } while (0)
    if (bid < 4096) { const int qbn = 31 - (bid >> 7), bhn = bid & 127; SB_LOAD(A, bhn >> 4, bhn & 15, qbn * 2 + 1); SB_LOAD(B, bhn >> 4, bhn & 15, qbn * 2); }
    for (int u = bid; u < 4096; u += G) {
        const int qb = 31 - (u >> 7), bh = u & 127, b = bh >> 4, h = bh & 15;
        const int q0 = qb * 128; const int tq = q0 + 16 * wave + fr;
        const size_t qrow = (size_t)(b * SEQL + tq);
        const bf16x8 bq0 = *(const bf16x8*)(P + qrow * 3072 + h * 64 + fq * 8), bq1 = *(const bf16x8*)(P + qrow * 3072 + h * 64 + 32 + fq * 8);
        f32x4 O[4];
#pragma unroll
        for (int i = 0; i < 4; ++i) O[i] = (f32x4){0.f, 0.f, 0.f, 0.f};
        float carry = 0.f; bool wdone_prev = false;
        const int kt_hi = q0 / 64 + 1;
        for (int kt0 = kt_hi; kt0 >= 0; kt0 -= 2) {
          { const int kt = kt0;
            LBAR();
            if (kt != kt_hi) { int fs = 0;
#pragma unroll
                for (int i = 0; i < 8; ++i) fs += flags[i];
                if (fs == 8) break; }
            { *(u32x4*)(Ks + ss_ * 144 + part_ * 16) = pkkA;
#pragma unroll
              for (int i = 0; i < 4; ++i) { *(bf16_t*)(VTs + swz144(part_ * 8 + 2 * i, ss_ * 2)) = (bf16_t)(pvvA[i] & 0xffffu); *(bf16_t*)(VTs + swz144(part_ * 8 + 2 * i + 1, ss_ * 2)) = (bf16_t)(pvvA[i] >> 16); } }
            if (kt > 1) SB_LOAD(A, b, h, kt - 2);
            LBAR();
            const bool wskip = wdone_prev || (64 * kt >= q0 + 16 * wave + 15);
            if (!wskip) {
            const bool need_mask = (64 * kt + 63 >= q0 + 16 * wave);
            float nl[4][4], lz[4][4];
            bf16x8 kf0[4], kf1[4];
#pragma unroll
            for (int io = 0; io < 4; ++io) { kf0[io] = ldsfrag(Ks + (16 * io + fr) * 144 + fq * 16); kf1[io] = ldsfrag(Ks + (16 * io + fr) * 144 + 64 + fq * 16); }
            f32x4 zt[4];
#pragma unroll
            for (int io = 0; io < 4; ++io) zt[io] = MFMA16(kf0[io], bq0, ((f32x4){0.f, 0.f, 0.f, 0.f}));
#pragma unroll
            for (int io = 0; io < 4; ++io) zt[io] = MFMA16(kf1[io], bq1, zt[io]);
#pragma unroll
            for (int io = 0; io < 4; ++io) { const f32x4 z = zt[io];
#pragma unroll
                for (int i = 0; i < 4; ++i) { const float zz = z[i];
                    const float sp = fmaxf(zz, 0.f) + __builtin_amdgcn_logf(1.f + __builtin_amdgcn_exp2f(-fabsf(zz)));
                    nl[io][i] = sp; lz[io][i] = zz - sp; } }
            if (need_mask) {
#pragma unroll
                for (int io = 0; io < 4; ++io)
#pragma unroll
                    for (int i = 0; i < 4; ++i) { const int key = 64 * kt + 16 * io + 4 * fq + i; if (key >= tq) { nl[io][i] = 0.f; lz[io][i] = -1e30f; } } }
            bf16x8 bh_[2];
#pragma unroll
            for (int ks = 0; ks < 2; ++ks) { u32x4 w; w.x = cvt_pk_bf16(nl[2 * ks][0], nl[2 * ks][1]); w.y = cvt_pk_bf16(nl[2 * ks][2], nl[2 * ks][3]); w.z = cvt_pk_bf16(nl[2 * ks + 1][0], nl[2 * ks + 1][1]); w.w = cvt_pk_bf16(nl[2 * ks + 1][2], nl[2 * ks + 1][3]); bh_[ks] = __builtin_bit_cast(bf16x8, w); }
            f32x4 tot = (f32x4){0.f, 0.f, 0.f, 0.f};
#pragma unroll
            for (int ks = 0; ks < 2; ++ks) tot = MFMA16(ones, bh_[ks], tot);
            float att[4][4];
#pragma unroll
            for (int io = 0; io < 4; ++io) { f32x4 sv = (f32x4){0.f, 0.f, 0.f, 0.f};
#pragma unroll
                for (int ks = 0; ks < 2; ++ks) sv = MFMA16(U[io][ks], bh_[ks], sv);
#pragma unroll
                for (int i = 0; i < 4; ++i) att[io][i] = __builtin_amdgcn_exp2f((lz[io][i] + carry) - sv[i]); }
            carry -= tot[0];
            bf16x8 pa[2];
#pragma unroll
            for (int ks = 0; ks < 2; ++ks) { u32x4 w; w.x = cvt_pk_bf16(att[2 * ks][0], att[2 * ks][1]); w.y = cvt_pk_bf16(att[2 * ks][2], att[2 * ks][3]); w.z = cvt_pk_bf16(att[2 * ks + 1][0], att[2 * ks + 1][1]); w.w = cvt_pk_bf16(att[2 * ks + 1][2], att[2 * ks + 1][3]); pa[ks] = __builtin_bit_cast(bf16x8, w); }
#pragma unroll
            for (int ks = 0; ks < 2; ++ks) { bf16x8 vf[4];
#pragma unroll
                for (int dt = 0; dt < 4; ++dt) { const u32x2 lo = *(const u32x2*)(VTs + swz144(16 * dt + fr, (32 * ks + 4 * fq) * 2)), hi = *(const u32x2*)(VTs + swz144(16 * dt + fr, (32 * ks + 16 + 4 * fq) * 2)); const u32x4 w = (u32x4){lo.x, lo.y, hi.x, hi.y}; vf[dt] = __builtin_bit_cast(bf16x8, w); }
#pragma unroll
                for (int dt = 0; dt < 4; ++dt) O[dt] = MFMA16(vf[dt], pa[ks], O[dt]); }
            }
            const bool wdone = (__builtin_amdgcn_ballot_w64(carry >= -152.0f) == 0ull);
            wdone_prev = wdone;
            if (lane == 0) flags[wave] = wdone ? 1 : 0;
          }
          if (kt0 == 0) break;
          { const int kt = kt0 - 1;
            LBAR();
            if (kt != kt_hi) { int fs = 0;
#pragma unroll
                for (int i = 0; i < 8; ++i) fs += flags[i];
                if (fs == 8) break; }
            { *(u32x4*)(Ks + ss_ * 144 + part_ * 16) = pkkB;
#pragma unroll
              for (int i = 0; i < 4; ++i) { *(bf16_t*)(VTs + swz144(part_ * 8 + 2 * i, ss_ * 2)) = (bf16_t)(pvvB[i] & 0xffffu); *(bf16_t*)(VTs + swz144(part_ * 8 + 2 * i + 1, ss_ * 2)) = (bf16_t)(pvvB[i] >> 16); } }
            if (kt > 1) SB_LOAD(B, b, h, kt - 2);
            LBAR();
            const bool wskip = wdone_prev || (64 * kt >= q0 + 16 * wave + 15);
            if (!wskip) {
            const bool need_mask = (64 * kt + 63 >= q0 + 16 * wave);
            float nl[4][4], lz[4][4];
            bf16x8 kf0[4], kf1[4];
#pragma unroll
            for (int io = 0; io < 4; ++io) { kf0[io] = ldsfrag(Ks + (16 * io + fr) * 144 + fq * 16); kf1[io] = ldsfrag(Ks + (16 * io + fr) * 144 + 64 + fq * 16); }
            f32x4 zt[4];
#pragma unroll
            for (int io = 0; io < 4; ++io) zt[io] = MFMA16(kf0[io], bq0, ((f32x4){0.f, 0.f, 0.f, 0.f}));
#pragma unroll
            for (int io = 0; io < 4; ++io) zt[io] = MFMA16(kf1[io], bq1, zt[io]);
#pragma unroll
            for (int io = 0; io < 4; ++io) { const f32x4 z = zt[io];
#pragma unroll
                for (int i = 0; i < 4; ++i) { const float zz = z[i];
                    const float sp = fmaxf(zz, 0.f) + __builtin_amdgcn_logf(1.f + __builtin_amdgcn_exp2f(-fabsf(zz)));
                    nl[io][i] = sp; lz[io][i] = zz - sp; } }
            if (need_mask) {
#pragma unroll
                for (int io = 0; io < 4; ++io)
#pragma unroll
                    for (int i = 0; i < 4; ++i) { const int key = 64 * kt + 16 * io + 4 * fq + i; if (key >= tq) { nl[io][i] = 0.f; lz[io][i] = -1e30f; } } }
            bf16x8 bh_[2];
#pragma unroll
            for (int ks = 0; ks < 2; ++ks) { u32x4 w; w.x = cvt_pk_bf16(nl[2 * ks][0], nl[2 * ks][1]); w.y = cvt_pk_bf16(nl[2 * ks][2], nl[2 * ks][3]); w.z = cvt_pk_bf16(nl[2 * ks + 1][0], nl[2 * ks + 1][1]); w.w = cvt_pk_bf16(nl[2 * ks + 1][2], nl[2 * ks + 1][3]); bh_[ks] = __builtin_bit_cast(bf16x8, w); }
            f32x4 tot = (f32x4){0.f, 0.f, 0.f, 0.f};
#pragma unroll
            for (int ks = 0; ks < 2; ++ks) tot = MFMA16(ones, bh_[ks], tot);
            float att[4][4];
#pragma unroll
            for (int io = 0; io < 4; ++io) { f32x4 sv = (f32x4){0.f, 0.f, 0.f, 0.f};
#pragma unroll
                for (int ks = 0; ks < 2; ++ks) sv = MFMA16(U[io][ks], bh_[ks], sv);
#pragma unroll
                for (int i = 0; i < 4; ++i) att[io][i] = __builtin_amdgcn_exp2f((lz[io][i] + carry) - sv[i]); }
            carry -= tot[0];
            bf16x8 pa[2];
#pragma unroll
            for (int ks = 0; ks < 2; ++ks) { u32x4 w; w.x = cvt_pk_bf16(att[2 * ks][0], att[2 * ks][1]); w.y = cvt_pk_bf16(att[2 * ks][2], att[2 * ks][3]); w.z = cvt_pk_bf16(att[2 * ks + 1][0], att[2 * ks + 1][1]); w.w = cvt_pk_bf16(att[2 * ks + 1][2], att[2 * ks + 1][3]); pa[ks] = __builtin_bit_cast(bf16x8, w); }
#pragma unroll
            for (int ks = 0; ks < 2; ++ks) { bf16x8 vf[4];
#pragma unroll
                for (int dt = 0; dt < 4; ++dt) { const u32x2 lo = *(const u32x2*)(VTs + swz144(16 * dt + fr, (32 * ks + 4 * fq) * 2)), hi = *(const u32x2*)(VTs + swz144(16 * dt + fr, (32 * ks + 16 + 4 * fq) * 2)); const u32x4 w = (u32x4){lo.x, lo.y, hi.x, hi.y}; vf[dt] = __builtin_bit_cast(bf16x8, w); }
#pragma unroll
                for (int dt = 0; dt < 4; ++dt) O[dt] = MFMA16(vf[dt], pa[ks], O[dt]); }
            }
            const bool wdone = (__builtin_amdgcn_ballot_w64(carry >= -152.0f) == 0ull);
            wdone_prev = wdone;
            if (lane == 0) flags[wave] = wdone ? 1 : 0;
          }
        }
        { const int un = u + G; if (un < 4096) { const int qbn = 31 - (un >> 7), bhn = un & 127; SB_LOAD(A, bhn >> 4, bhn & 15, qbn * 2 + 1); SB_LOAD(B, bhn >> 4, bhn & 15, qbn * 2); } }
#pragma unroll
        for (int dt = 0; dt < 4; ++dt) { u32x2 w; w.x = cvt_pk_bf16(O[dt][0], O[dt][1]); w.y = cvt_pk_bf16(O[dt][2], O[dt][3]);
            *(u32x2*)(AO + qrow * DM + h * 64 + 16 * dt + 4 * fq) = w; }
    }
}

__device__ __forceinline__ void ffn_fix_phase(const Params& p, int layer, int bid, int G, int tid) {
    const float* side = (const float*)(p.ws + WS_BIG + 176 * MiB); bf16_t* act = (bf16_t*)(p.ws + WS_BIG);
    const float* cw = p.in[I_FFN_CW] + (size_t)layer * 3 * 5632; const float* cb = p.in[I_FFN_CB] + (size_t)layer * 5632;
    for (int idx = bid * 512 + tid; idx < 128 * 2 * 704; idx += G * 512) {
        const int q = idx % 704, r = idx / 704, tau = r & 1, pm = r >> 1;
        if ((pm & 15) == 0) continue;
        const int c = q * 4, col = (c >> 7) * 256 + (c & 127);
        const float* s0 = side + ((size_t)pm * 4 + tau) * 5632 + col;
        const float* s1 = tau ? side + ((size_t)pm * 4) * 5632 + col : side + ((size_t)(pm - 1) * 4 + 3) * 5632 + col;
        const float* s2 = tau ? side + ((size_t)(pm - 1) * 4 + 3) * 5632 + col : side + ((size_t)(pm - 1) * 4 + 2) * 5632 + col;
        const f32x4 g = *(const f32x4*)(cb + c) + *(const f32x4*)(cw + 2 * 5632 + c) * *(const f32x4*)s0 + *(const f32x4*)(cw + 5632 + c) * *(const f32x4*)s1 + *(const f32x4*)(cw + c) * *(const f32x4*)s2;
        const f32x4 v = *(const f32x4*)(cb + FFD + c) + *(const f32x4*)(cw + 2 * 5632 + FFD + c) * *(const f32x4*)(s0 + 128) + *(const f32x4*)(cw + 5632 + FFD + c) * *(const f32x4*)(s1 + 128) + *(const f32x4*)(cw + FFD + c) * *(const f32x4*)(s2 + 128);
        u32x2 w; w.x = cvt_pk_bf16(fast_silu(g[0]) * v[0], fast_silu(g[1]) * v[1]); w.y = cvt_pk_bf16(fast_silu(g[2]) * v[2], fast_silu(g[3]) * v[3]);
        *(u32x2*)(act + ((size_t)(c >> 6) * NTOK + (pm * 256 + tau)) * 64 + (c & 63)) = w;
    }
}

__device__ __forceinline__ void final_phase(const Params& p, int gw, int NGW, int lane) {
    const float* rssp = (const float*)(p.ws + WS_RSSP); const bf16_t* XB = (const bf16_t*)(p.ws + WS_XB);
    f32x4 wv[4];
#pragma unroll
    for (int j = 0; j < 4; ++j) wv[j] = ((const f32x4*)p.in[I_FINNW] + lane)[64 * j];
    for (int m = gw; m < NTOK; m += NGW) { const float rs = row_rstd(rssp, m); f32x4* xr = (f32x4*)(p.out + (size_t)m * DM) + lane; const u32x2* xi = (const u32x2*)(XB + (size_t)m * DM) + lane;
#pragma unroll
        for (int j = 0; j < 4; ++j) { const u32x2 w = xi[64 * j]; f32x4 v = (f32x4){bflo(w.x), bfhi(w.x), bflo(w.y), bfhi(w.y)}; __builtin_nontemporal_store(v * rs * wv[j], xr + 64 * j); } }
}

#define XB_TMO      128
#define XB_XCNT(j)  (256  + 64 * (j))
#define XB_XSUB(j)  (1280 + 64 * (j))
#define XB_XGEN(j)  (2304 + 64 * (j))
#define XB_TOP      3328
#define XB_TOPGEN   3392
#define XCD_BAR_WORDS 3456
#define XB_SPIN_CAP (1u << 22)
__device__ __forceinline__ unsigned xb_ld(unsigned* p)              { return __hip_atomic_load(p, __ATOMIC_RELAXED, __HIP_MEMORY_SCOPE_AGENT); }
__device__ __forceinline__ unsigned xb_add(unsigned* p, unsigned v) { return __hip_atomic_fetch_add(p, v, __ATOMIC_RELAXED, __HIP_MEMORY_SCOPE_AGENT); }
__device__ __forceinline__ unsigned xb_xcc_id() { return (unsigned)__builtin_amdgcn_s_getreg((3 << 11) | 20) & 0xFu; }
#define XB_SPIN(cond, bar) do { unsigned _sp = 0; while (cond) { __builtin_amdgcn_s_sleep(1); \
    if ((++_sp & 255u) == 0u) { if (xb_ld(&(bar)[XB_TMO])) break; if (_sp > XB_SPIN_CAP) { atomicAdd(&(bar)[XB_TMO], 1u); break; } } } } while (0)
struct XcdBarrier { unsigned* bar; unsigned x; volatile LAS unsigned* st; };
__device__ __forceinline__ XcdBarrier xcd_barrier_post(unsigned* bar, volatile LAS unsigned* st) {
    XcdBarrier b; b.bar = bar; b.x = xb_xcc_id(); b.st = st;
    if (threadIdx.x == 0) (void)xb_add(&bar[XB_XCNT(b.x)], 1u);
    return b;
}
__device__ __forceinline__ void xcd_barrier_complete(unsigned* bar, unsigned x, unsigned& nloc, unsigned& nx) {
    const unsigned G = gridDim.x * gridDim.y * gridDim.z;
    unsigned sum, cnt, mine, sp = 0u;
    for (;;) {
        sum = 0u; cnt = 0u; mine = 0u;
#pragma unroll 1
        for (unsigned j = 0; j < 16; ++j) { const unsigned c = xb_ld(&bar[XB_XCNT(j)]); sum += c; cnt += (c > 0u) ? 1u : 0u; mine = (j == x) ? c : mine; }
        if (sum == G) break;
        __builtin_amdgcn_s_sleep(1);
        if ((++sp & 255u) == 0u) { if (xb_ld(&bar[XB_TMO])) break; if (sp > XB_SPIN_CAP) { atomicAdd(&bar[XB_TMO], 1u); break; } }
    }
    nloc = mine > 0u ? mine : 1u; nx = cnt > 0u ? cnt : 1u;
}
__device__ __forceinline__ void xcd_barrier(const XcdBarrier& b) {
    asm volatile("s_waitcnt vmcnt(0)" ::: "memory");
    __syncthreads();
    if (threadIdx.x == 0) {
        unsigned* bar = b.bar; asm volatile("" : "+s"(bar));
        __builtin_amdgcn_s_waitcnt(0);
        unsigned nloc = b.st[0], nx = b.st[1];
        if (nloc == 0u) { xcd_barrier_complete(bar, b.x, nloc, nx); b.st[0] = nloc; b.st[1] = nx; }
        const unsigned old = xb_add(&bar[XB_XSUB(b.x)], 1u);
        const unsigned gen = old / nloc;
        if (old + 1u == (gen + 1u) * nloc) {
            __builtin_amdgcn_fence(__ATOMIC_RELEASE, "agent");
            asm volatile("s_waitcnt vmcnt(0)" ::: "memory");
            const unsigned og = xb_add(&bar[XB_TOP], 1u);
            const unsigned tg = og / nx;
            if (og + 1u == (tg + 1u) * nx) xb_add(&bar[XB_TOPGEN], 1u);
            else XB_SPIN(xb_ld(&bar[XB_TOPGEN]) == tg, bar);
            __builtin_amdgcn_fence(__ATOMIC_ACQUIRE, "agent");
            xb_add(&bar[XB_XGEN(b.x)], 1u);
            asm volatile("s_waitcnt vmcnt(0)" ::: "memory");
        } else {
            XB_SPIN(xb_ld(&bar[XB_XGEN(b.x)]) == gen, bar);
            __builtin_amdgcn_fence(__ATOMIC_ACQUIRE, "agent");
            asm volatile("s_waitcnt vmcnt(0)" ::: "memory");
        }
    }
    __syncthreads();
}
constexpr size_t WS_BARW = 102 * MiB;
#ifdef DBG
__device__ __noinline__ void dbg_scan(const void* ptr, size_t nbytes, int is_f32, unsigned code, unsigned* dbg, int gtid, int gthreads) {
    const u32x4* q = (const u32x4*)ptr; const size_t n = nbytes / 16; bool bad = false;
    for (size_t i = gtid; i < n; i += gthreads) { const u32x4 v = q[i];
#pragma unroll
        for (int e = 0; e < 4; ++e) { if (is_f32) bad |= ((v[e] & 0x7f800000u) == 0x7f800000u); else bad |= ((v[e] & 0x7f80u) == 0x7f80u) | ((v[e] & 0x7f800000u) == 0x7f800000u); } }
    if (bad) atomicMin(dbg, code);
}
#define SCAN(ptr, nbytes, isf, code) do { dbg_scan((ptr), (nbytes), (isf), (code), dbgw, bid * 512 + (int)threadIdx.x, G * 512); grid.sync(); } while (0)
#else
#define SCAN(ptr, nbytes, isf, code) do { } while (0)
#endif
constexpr int LDS_BYTES = 147456;
__global__ void __launch_bounds__(512, 2) mega_fwd(Params p) {
    extern __shared__ __attribute__((aligned(16))) unsigned char lds[];
    cg::grid_group grid = cg::this_grid();
    const int G = gridDim.x, bid = blockIdx.x; const int NGW = G * 8;
    int tid, lane, wave, gw;
#define FRESH() do { tid = threadIdx.x; asm volatile("" : "+v"(tid)); lane = tid & 63; wave = __builtin_amdgcn_readfirstlane(tid >> 6); gw = bid * 8 + wave; } while (0)
    FRESH();
    unsigned char* ws = p.ws;
    float* RSSP0 = (float*)(ws + WS_RSSP); float* RSSP1 = RSSP0 + RSSP_STRIDE;
    bf16_t* XB = (bf16_t*)(ws + WS_XB); bf16_t* BIG = (bf16_t*)(ws + WS_BIG);
#ifdef DBG
    unsigned* dbgw = (unsigned*)(ws + 102 * MiB + 65536);
#endif

#ifndef PH
#define PH 0xFFFF
#endif
#define ON(k) ((PH >> (k)) & 1)
#ifndef REP
#define REP 0
#endif
#define NREP(k) (((REP) >> (k)) & 1)
#define RUN(k, call) do { if (ON(k)) { for (int rep_ = NREP(k); rep_ >= 0; --rep_) { const int dry = rep_; (void)dry; FRESH(); call; if (rep_) grid.sync(); } } } while (0)
    { volatile LAS unsigned* bst_ = (volatile LAS unsigned*)(LAS unsigned char*)(lds + LDS_BYTES - 16); if (threadIdx.x == 0) { bst_[0] = 0u; bst_[1] = 0u; } }
    __syncthreads();
    const XcdBarrier xbar = xcd_barrier_post((unsigned*)(ws + WS_BARW), (volatile LAS unsigned*)(LAS unsigned char*)(lds + LDS_BYTES - 16));
    RUN(0, prep_phase(p, lds, gw, NGW, wave, lane));
#ifdef XSYNC
    for (int i_ = 0; i_ < XSYNC; ++i_) grid.sync();
#endif
    if (p.out == nullptr) grid.sync();
    xcd_barrier(xbar);
    SCAN(XB, (size_t)NTOK * DM * 2, 0, 1); SCAN(RSSP0, (size_t)NTOK * 16, 1, 2); SCAN(ws + WS_W, W_END - WS_W, 0, 3);
    for (int layer = 0; layer < 4; ++layer) {
        if (layer == 1) { RUN(1, pool_dlt_phase(p, lds, bid, G, tid)); }
        else if (layer == 2) {
            pg8::Sched S; S.init(128, 21, G, bid, 0, 256L * 2048, 0, 256L * 2048);
            pg8::EpiSsdIn E{BIG, RSSP0, (float*)(ws + WS_BIG + BIG_SSD_DT), p.in[I_SSD_CW], p.in[I_SSD_CB], (float*)((unsigned char*)p.out + XBR_HALO)};
            FRESH(); pg8::gemm_phase<pg8::EpiSsdIn>(lds, XB, (const bf16_t*)(ws + W_SSD_IN), 1024, 1024, S, E, tid);
        }
        else {
            pg8::Sched S; pg8::EpiProj E; const bf16_t* Bt;
            if (layer == 0) { Bt = (const bf16_t*)(ws + W_GLA_IN); S.init(128, 13, G, bid, 0, 256L * 2048, 0, 256L * 2048); E = pg8::EpiProj{BIG, 3072, RSSP0, 12, (float*)(ws + WS_BIG + BIG_GLA_GLR), 16}; }
            else if (layer == 2) { Bt = (const bf16_t*)(ws + W_SSD_IN); S.init(128, 21, G, bid, 0, 256L * 2048, 0, 256L * 2048); E = pg8::EpiProj{BIG, 5120, RSSP0, 20, (float*)(ws + WS_BIG + BIG_SSD_DT), 32}; }
            else { Bt = (const bf16_t*)(ws + W_SB_QKV); S.init(128, 12, G, bid, 0, 256L * 2048, 0, 256L * 2048); E = pg8::EpiProj{BIG, 3072, RSSP0, -1, nullptr, 0}; }
            RUN(2, pg8::gemm_phase<pg8::EpiProj>(lds, XB, Bt, 1024, 1024, S, E, tid));
        }
        xcd_barrier(xbar);
        if (layer == 0) { SCAN(BIG, (size_t)NTOK * 3072 * 2, 0, 10); SCAN(ws + WS_BIG + BIG_GLA_GLR, (size_t)NTOK * 64, 1, 11); }
        else if (layer == 1) { SCAN(BIG, (size_t)NTOK * 1024 * 2, 0, 20); }
        else if (layer == 2) { SCAN(BIG, (size_t)NTOK * 5120 * 2, 0, 30); SCAN(ws + WS_BIG + BIG_SSD_DT, (size_t)NTOK * 128, 1, 31); }
        else { SCAN(BIG, (size_t)NTOK * 3072 * 2, 0, 40); }
        if (layer == 0) { RUN(3, gla1_phase(p, lds, bid, G, tid)); xcd_barrier(xbar); SCAN(ws + WS_BIG + BIG_GLA_KDT, 32 * MiB, 0, 12); SCAN(ws + WS_XB, 64 * MiB, 0, 13); for (int gp_ = 1; gp_ <= 2; ++gp_) { FRESH(); gla_scan_phase(p, lds, bid, G, tid, wave, lane, gp_); if (gp_ == 1) { xcd_barrier(xbar); FRESH(); gla_combine_phase(p, bid, G, tid); xcd_barrier(xbar); } } xcd_barrier(xbar); SCAN(ws + WS_BIG + BIG_GLA_OPRE, 64 * MiB, 0, 14); if (ON(5)) { FRESH(); gla3_phase(p, gw, NGW, lane); } xcd_barrier(xbar); SCAN(ws + WS_BIG + BIG_GLA_OPRE, 64 * MiB, 0, 15); }
        else if (layer == 2) { FRESH(); ssd_dt_fix_phase(p, lds, bid, G, tid); xcd_barrier(xbar); RUN(6, ssd_scan_phase(p, lds, bid, G, tid, wave, lane, dry)); xcd_barrier(xbar); SCAN(BIG, (size_t)NTOK * 5120 * 2, 0, 32); if (ON(7)) { FRESH(); ssd3_phase(p, gw, NGW, lane); } xcd_barrier(xbar); SCAN(BIG, (size_t)NTOK * 5120 * 2, 0, 33); }
        else if (layer == 3) { RUN(8, sb_attn_phase(p, lds, bid, G, tid, wave, lane)); xcd_barrier(xbar); SCAN(ws + WS_BIG + BIG_SB_AO, 64 * MiB, 0, 41); }
        {
            pg8::Sched S; pg8::EpiResid E{XB, RSSP1, nullptr, nullptr, 0}; const bf16_t* A; const bf16_t* Bt; int lda, K;
            if (layer == 0) { A = (const bf16_t*)(ws + WS_BIG + BIG_GLA_OPRE); Bt = (const bf16_t*)(ws + W_GLA_OUT); lda = 1024; K = 1024; S.init(128, 4, G, bid, 0, 256L * 2048, 0, 256L * 2048); }
            else if (layer == 1) { A = BIG; Bt = (const bf16_t*)(ws + W_POOL); lda = 1024; K = 256; S.init(128, 4, G, bid, 0, 256L * 2048, 512, 256L * 512); E.bias = p.in[I_POOL_B]; E.scale = p.in[I_POOL_SC]; }
            else if (layer == 2) { A = BIG + 2048; Bt = (const bf16_t*)(ws + W_SSD_OUT); lda = 5120; K = 2048; S.init(128, 4, G, bid, 0, 256L * 10240, 0, 256L * 4096); }
            else { A = (const bf16_t*)(ws + WS_BIG + BIG_SB_AO); Bt = (const bf16_t*)(ws + W_SB_OUT); lda = 1024; K = 1024; S.init(128, 4, G, bid, 0, 256L * 2048, 0, 256L * 2048); }
            RUN(9, (E.dry = dry, pg8::gemm_phase<pg8::EpiResid>(lds, A, Bt, lda, K, S, E, tid)));
        }
        xcd_barrier(xbar);
        SCAN(p.out, (size_t)NTOK * DM * 4, 1, 10 * (layer + 1) + 5); SCAN(RSSP1, (size_t)NTOK * 16, 1, 10 * (layer + 1) + 6);
        {
            pg8::Sched S; S.init(128, 22, G, bid, 0, 256L * 2048, 0, 256L * 2048);
            pg8::EpiFfnUp E{BIG, RSSP1, p.in[I_FFN_CW] + (size_t)layer * 3 * 5632, p.in[I_FFN_CB] + (size_t)layer * 5632, (float*)(ws + WS_BIG + 176 * MiB)};
            RUN(10, pg8::gemm_phase<pg8::EpiFfnUp>(lds, XB, (const bf16_t*)(ws + WS_W + layer * W_FFN_STRIDE), 1024, 1024, S, E, tid));
        }
        xcd_barrier(xbar);
        FRESH(); ffn_fix_phase(p, layer, bid, G, tid);
        xcd_barrier(xbar);
        SCAN(BIG, (size_t)NTOK * FFD * 2, 0, 10 * (layer + 1) + 7);
        {
            pg8::Sched S; S.init(128, 4, G, bid, 0, 256L * 128, 0, 256L * 5632);
            pg8::EpiResid E{XB, RSSP0, nullptr, nullptr, 0};
            RUN(11, (E.dry = dry, pg8::gemm_phase<pg8::EpiResid>(lds, BIG, (const bf16_t*)(ws + WS_W + layer * W_FFN_STRIDE + W_FFN_DOWN_OFF), 64, FFD, S, E, tid, (size_t)NTOK * 128)));
        }
        xcd_barrier(xbar);
        SCAN(p.out, (size_t)NTOK * DM * 4, 1, 10 * (layer + 1) + 8);
    }
    if (ON(12)) { FRESH(); final_phase(p, gw, NGW, lane); }
#ifdef DBG
    xcd_barrier(xbar);
    if (bid == 0 && threadIdx.x == 0) { const unsigned dv = *dbgw; p.out[0] = dv > 1000u ? 0.f : 100.f * (float)dv; }
#endif
}

extern "C" void kernel_launch(void* const* d_in, const int* in_sizes, int n_in, void* d_out, int out_size, void* d_ws, size_t ws_size, hipStream_t stream) {
    static int grid = 0;
    if (grid == 0) {
        if (n_in != 26 || out_size != NTOK * DM || ws_size < WS_NEED) { fprintf(stderr, "kernel_launch: unexpected problem (n_in %d, out %d, ws %zu)\n", n_in, out_size, ws_size); grid = -1; return; }
        int dev = 0, cus = 0, per_cu = 0;
        hipGetDevice(&dev); hipDeviceGetAttribute(&cus, hipDeviceAttributeMultiprocessorCount, dev);
        hipFuncSetAttribute((const void*)mega_fwd, hipFuncAttributeMaxDynamicSharedMemorySize, LDS_BYTES);
        hipOccupancyMaxActiveBlocksPerMultiprocessor(&per_cu, (const void*)mega_fwd, 512, LDS_BYTES);
        if (per_cu < 1) per_cu = 1;
        grid = cus * 1;
        (void)hipGetLastError();
    }
    if (grid < 0) return;
    if (hipMemsetAsync((unsigned char*)d_ws + WS_BARW, 0, 16384, stream) != hipSuccess) { fprintf(stderr, "kernel_launch: memset failed\n"); return; }
    Params p{};
    for (int i = 0; i < 26; ++i) p.in[i] = (const float*)d_in[i];
    p.out = (float*)d_out; p.ws = (unsigned char*)d_ws;
#ifdef DBG
    hipMemsetAsync((unsigned char*)d_ws + 102 * MiB + 65536, 0x7f, 64, stream);
#endif
    void* args[] = {&p};
    hipError_t e = hipLaunchCooperativeKernel((const void*)mega_fwd, dim3(grid), dim3(512), args, LDS_BYTES, stream);
    if (e != hipSuccess) fprintf(stderr, "cooperative launch failed: %s (grid %d)\n", hipGetErrorString(e), grid);
}
```
